# Optimizing an MI355X kernel written in HIP

```python
import jax, jax.numpy as jnp
from jax import lax
import numpy as np

D_MODEL = 1024
BATCH = 4
SEQ = 8192
DEPTH = 4

SB_HEADS = 8
SB_HEAD_DIM = 64
SB_WIDTH = SB_HEADS * SB_HEAD_DIM
SB_BLOCK = 128
POOL_WINDOWS = (2, 4, 8, 16)
POOL_GROUPS = 4
POOL_GROUP_DIM = 64
POOL_WIDTH = POOL_GROUPS * POOL_GROUP_DIM
GM_GROUPS = 4
GM_GROUP_DIM = 64
GM_WIDTH = GM_GROUPS * GM_GROUP_DIM
GM_CHUNK = 128
N_BRANCH = 3
D_FF = 4 * D_MODEL
RMS_EPS = 1e-6
IN_SIZES = (SB_WIDTH, SB_WIDTH, SB_WIDTH, POOL_WIDTH, GM_WIDTH, GM_WIDTH, N_BRANCH * D_MODEL)
D_IN = sum(IN_SIZES)
IN_SPLITS = tuple(int(s) for s in np.cumsum(IN_SIZES)[:-1])

kernel_name = "hybrid_stickbreak_pool_gmlp_block"


def rms_norm(x, gain):
    xf = x.astype(jnp.float32)
    y = xf * lax.rsqrt(jnp.mean(xf * xf, axis=-1, keepdims=True) + RMS_EPS)
    return (y * gain.astype(jnp.float32)).astype(x.dtype)


def stick_breaking_attention(q, k, v):
    B, S, H, Dh = q.shape
    scale = Dh ** -0.5
    outs = []
    for blk in range(S // SB_BLOCK):
        q0 = blk * SB_BLOCK
        q1 = q0 + SB_BLOCK
        qb = q[:, q0:q1]
        kb = k[:, :q1]
        vb = v[:, :q1]
        z = jnp.einsum('bthd,bshd->bhts', qb, kb).astype(jnp.float32) * scale
        t_idx = q0 + jnp.arange(SB_BLOCK)[:, None]
        s_idx = jnp.arange(q1)[None, :]
        strict = s_idx < t_idx
        log_not = jnp.where(strict, jax.nn.log_sigmoid(-z), 0.0)
        suffix = lax.cumsum(log_not, axis=3, reverse=True) - log_not
        a = jnp.where(strict, jnp.exp(jax.nn.log_sigmoid(z) + suffix), 0.0).astype(v.dtype)
        outs.append(jnp.einsum('bhts,bshd->bthd', a, vb))
    return jnp.concatenate(outs, axis=1)


def multiscale_pool(p, w_pool, pool_scale):
    B, S, _ = p.shape
    pg = p.reshape(B, S, POOL_GROUPS, POOL_GROUP_DIM)
    csum = jnp.cumsum(pg.astype(jnp.float32), axis=1)
    pos = jnp.arange(S, dtype=jnp.float32)
    pooled = []
    for g, w in enumerate(POOL_WINDOWS):
        cg = csum[:, :, g]
        shifted = jnp.pad(cg, ((0, 0), (w, 0), (0, 0)))[:, :S]
        count = jnp.minimum(pos + 1.0, float(w))[None, :, None]
        pooled.append((cg - shifted) / count - pg[:, :, g].astype(jnp.float32))
    pooled = jnp.stack(pooled, axis=2).astype(p.dtype)
    mixed = jnp.einsum('bsgc,gcd->bsgd', pooled, w_pool)
    return mixed.reshape(B, S, POOL_WIDTH) * pool_scale


def chunked_spatial_gating(u, v, gm_gain, w_spatial, b_spatial):
    B, S, _ = u.shape
    u = jax.nn.gelu(u)
    v = rms_norm(jax.nn.gelu(v), gm_gain)
    n_chunks = S // GM_CHUNK
    vc = v.reshape(B, n_chunks, GM_CHUNK, GM_GROUPS, GM_GROUP_DIM)
    causal = jnp.tril(jnp.ones((GM_CHUNK, GM_CHUNK), dtype=bool))
    ws = jnp.where(causal[None], w_spatial, 0.0).astype(v.dtype)
    mixed = jnp.einsum('gtp,bnpgc->bntgc', ws, vc) + b_spatial.T[:, :, None]
    return u * mixed.reshape(B, S, GM_WIDTH)


def setup_inputs(seed: int = 0) -> dict:
    key = jax.random.key(seed)
    ks = jax.random.split(key, 18)

    def nrm(k, shape, scale):
        return jax.random.normal(k, shape, jnp.float32) * scale

    def gain(k, shape):
        return 1.0 + 0.05 * jax.random.normal(k, shape, jnp.float32)

    return {
        "x": nrm(ks[0], (BATCH, SEQ, D_MODEL), 1.0),
        "w_in": nrm(ks[1], (DEPTH, D_MODEL, D_IN), D_MODEL ** -0.5),
        "w_pool": nrm(ks[2], (DEPTH, POOL_GROUPS, POOL_GROUP_DIM, POOL_GROUP_DIM), POOL_GROUP_DIM ** -0.5),
        "pool_scale": gain(ks[3], (DEPTH, POOL_WIDTH)),
        "gm_gain": gain(ks[4], (DEPTH, GM_WIDTH)),
        "w_spatial": nrm(ks[5], (DEPTH, GM_GROUPS, GM_CHUNK, GM_CHUNK), GM_CHUNK ** -0.5),
        "b_spatial": gain(ks[6], (DEPTH, GM_GROUPS, GM_CHUNK)),
        "w_br_sb": nrm(ks[7], (DEPTH, SB_WIDTH, D_MODEL), SB_WIDTH ** -0.5),
        "w_br_pool": nrm(ks[8], (DEPTH, POOL_WIDTH, D_MODEL), POOL_WIDTH ** -0.5),
        "w_br_gm": nrm(ks[9], (DEPTH, GM_WIDTH, D_MODEL), GM_WIDTH ** -0.5),
        "w_out": nrm(ks[10], (DEPTH, D_MODEL, D_MODEL), D_MODEL ** -0.5),
        "g_mix_pre": gain(ks[11], (DEPTH, D_MODEL)),
        "g_mix_post": gain(ks[12], (DEPTH, D_MODEL)),
        "g_ff_pre": gain(ks[13], (DEPTH, D_MODEL)),
        "g_ff_post": gain(ks[14], (DEPTH, D_MODEL)),
        "w_ff_in": nrm(ks[15], (DEPTH, D_MODEL, D_FF), D_MODEL ** -0.5),
        "w_ff_out": nrm(ks[16], (DEPTH, D_FF, D_MODEL), D_FF ** -0.5),
    }


def reference(x, w_in, w_pool, pool_scale, gm_gain, w_spatial, b_spatial, w_br_sb, w_br_pool,
              w_br_gm, w_out, g_mix_pre, g_mix_post, g_ff_pre, g_ff_post, w_ff_in, w_ff_out):
    B, S, D = x.shape
    for l in range(DEPTH):
        h = rms_norm(x, g_mix_pre[l])
        proj = h @ w_in[l]
        q, k, v, p_in, gm_u, gm_v, gate_in = jnp.split(proj, IN_SPLITS, axis=-1)
        o_sb = stick_breaking_attention(q.reshape(B, S, SB_HEADS, SB_HEAD_DIM),
                                        k.reshape(B, S, SB_HEADS, SB_HEAD_DIM),
                                        v.reshape(B, S, SB_HEADS, SB_HEAD_DIM)).reshape(B, S, SB_WIDTH)
        o_pool = multiscale_pool(p_in, w_pool[l], pool_scale[l])
        o_gm = chunked_spatial_gating(gm_u, gm_v, gm_gain[l], w_spatial[l], b_spatial[l])
        gates = jax.nn.sigmoid(gate_in.reshape(B, S, N_BRANCH, D))
        merged = (gates[:, :, 0] * (o_sb @ w_br_sb[l])
                  + gates[:, :, 1] * (o_pool @ w_br_pool[l])
                  + gates[:, :, 2] * (o_gm @ w_br_gm[l]))
        x = x + rms_norm(merged @ w_out[l], g_mix_post[l])
        h = rms_norm(x, g_ff_pre[l])
        ff = jnp.square(jax.nn.relu(h @ w_ff_in[l])) @ w_ff_out[l]
        x = x + rms_norm(ff, g_ff_post[l])
    return x
```

```cpp
#include <hip/hip_runtime.h>
#include <hip/hip_cooperative_groups.h>
#include <cstdio>
#include <cstdint>
namespace cg = cooperative_groups;
namespace pg8 {
#define PG8_LAS __attribute__((address_space(3)))
typedef unsigned short bf16_t;
typedef short bf16x8 __attribute__((ext_vector_type(8)));
typedef float f32x4 __attribute__((ext_vector_type(4)));
typedef unsigned u32x4 __attribute__((ext_vector_type(4)));
constexpr int BM = 256, BK = 64, HALF = 128, HTB = HALF * BK * 2  , STAGE_BYTES = 8 * HTB, NXCD = 8, WGM = 8;

__host__ __device__ __forceinline__ int lds_byte(int r, int c) { const int st = (r >> 4) * 2 + (c >> 5), rr = r & 15, cc = c & 31, ob = rr * 64 + cc * 2; return st * 1024 + (ob ^ (((ob >> 9) & 1) << 5)); }
__host__ __device__ __forceinline__ void stage_rc(int b, int& R, int& C) { const int st = b / 1024, sb = b % 1024, swz = sb ^ (((sb >> 9) & 1) << 5); R = (st >> 1) * 16 + swz / 64; C = (st & 1) * 32 + (swz % 64) / 2; }
__host__ __device__ __forceinline__ int perm32(int rho) { const int n = rho >> 4, i = rho & 15; return 8 * (i >> 2) + 4 * n + (i & 3); }

struct Unit { int pm, pn; };
struct Gemm { const bf16_t* A; const bf16_t* Bt; int M, N, K; };

struct StaticOrder {
    int nM, nN, nwg, G, c;
    __host__ __device__ void init(int M, int N, int G_, int c_) { nM = M / BM; nN = N / BM; nwg = nM * nN; G = G_; c = c_; }
    __host__ __device__ bool next(int i, Unit& u) const {
        const long L = (long)i * G + c; if (L >= nwg) return false;
        int wgid = (int)L; { const int q = nwg / NXCD, r = nwg % NXCD, xcd = wgid % NXCD, off = wgid / NXCD; wgid = (xcd < r ? xcd * (q + 1) : r * (q + 1) + (xcd - r) * q) + off; }
        const int nig = WGM * nN, gid = wgid / nig, fm = gid * WGM, gsz = (nM - fm) < WGM ? (nM - fm) : WGM;
        u.pm = fm + ((wgid % nig) % gsz); u.pn = (wgid % nig) / gsz; return true;
    }
    __device__ __forceinline__ void a_ready(const Unit&) const {}
    __device__ __forceinline__ void done(const Unit&) const {}
};

__device__ __forceinline__ unsigned cvt_pk_bf16(float lo, float hi) { unsigned r; asm volatile("v_cvt_pk_bf16_f32 %0, %1, %2" : "=v"(r) : "v"(lo), "v"(hi)); return r; }
typedef __bf16 bf16v2 __attribute__((ext_vector_type(2)));
typedef float f32v2 __attribute__((ext_vector_type(2)));
__device__ __forceinline__ unsigned pk2(float lo, float hi) { f32v2 v = {lo, hi}; bf16v2 r = __builtin_convertvector(v, bf16v2); return __builtin_bit_cast(unsigned, r); }
__device__ __forceinline__ float bf_lo(unsigned w) { return __builtin_bit_cast(float, w << 16); }
__device__ __forceinline__ float bf_hi(unsigned w) { return __builtin_bit_cast(float, w & 0xffff0000u); }
__device__ __forceinline__ float sigmoid_f(float x) { return __builtin_amdgcn_rcpf(1.0f + __builtin_amdgcn_exp2f(-1.4426950409f * x)); }
__device__ __forceinline__ float gelu_tanh_f(float x) { const float t = x * (1.0f + 0.044715f * x * x); return x * __builtin_amdgcn_rcpf(1.0f + __builtin_amdgcn_exp2f(-2.3022081981f * t)); }
constexpr float QSCALE = 0.125f * 1.4426950409f;

__device__ __forceinline__ void scale_acc_by_gate_ratio(f32x4 (&acc)[2][2][4][2], const bf16_t* ga_base, bool single, const Unit& u, int wr, int wc, int fr, int fq) {
    const size_t row0 = (size_t)(u.pm * BM + wr * 64 + fr); const int col0 = u.pn * BM + wc * 32 + 8 * fq;
    const bf16_t* gp = ga_base + row0 * 3072 + col0;
#define GSEL(c, a, b) ((c) ? (a) : (b))
#define GSCALE(AI, V, XW, YW, USEY) do { const float x_ = bf_lo(XW), x2_ = bf_hi(XW), y_ = bf_lo(YW), y2_ = bf_hi(YW); \
        const float f_ = (USEY) ? GSEL(single, y_, 1.0f) : GSEL(single, x_, x_ * __builtin_amdgcn_rcpf(y_)); \
        const float f2_ = (USEY) ? GSEL(single, y2_, 1.0f) : GSEL(single, x2_, x2_ * __builtin_amdgcn_rcpf(y2_)); (void)AI; V##A *= f_; V##B *= f2_; } while (0)
#pragma unroll
    for (int bt = 0; bt < 2; ++bt) {
        u32x4 X[8], Y[8];
#pragma unroll
        for (int m = 0; m < 4; ++m)
#pragma unroll
            for (int bj = 0; bj < 2; ++bj) {
                const bf16_t* p0 = gp + (size_t)(m * 16) * 3072 + bj * HALF; const bf16_t* p1 = p0 + (size_t)HALF * 3072;
                const bf16_t* px = bt == 0 ? p0 : GSEL(single, p0, p1);
                const bf16_t* py = bt == 0 ? GSEL(single, p1, p0 + 1024) : GSEL(single, p0, p1 + 1024);
                X[m * 2 + bj] = *(const u32x4*)px; Y[m * 2 + bj] = *(const u32x4*)py;
            }
        __builtin_amdgcn_sched_barrier(0);
#pragma unroll
        for (int m = 0; m < 4; ++m)
#pragma unroll
            for (int bj = 0; bj < 2; ++bj) {
                const u32x4 gx = X[m * 2 + bj], gy = Y[m * 2 + bj];
                const unsigned xw[4] = {gx.x, gx.y, gx.z, gx.w}, yw[4] = {gy.x, gy.y, gy.z, gy.w};
#pragma unroll
                for (int w = 0; w < 4; ++w) {
                    const float x_ = bf_lo(xw[w]), x2_ = bf_hi(xw[w]), y_ = bf_lo(yw[w]), y2_ = bf_hi(yw[w]);
                    const float q_ = x_ * __builtin_amdgcn_rcpf(y_), q2_ = x2_ * __builtin_amdgcn_rcpf(y2_);
                    const int n = w >> 1, e = (w & 1) * 2;
                    if (bt == 0) {
                        acc[0][bj][m][n][e] *= GSEL(single, x_, q_); acc[0][bj][m][n][e + 1] *= GSEL(single, x2_, q2_);
                        acc[1][bj][m][n][e] *= GSEL(single, y_, 1.0f); acc[1][bj][m][n][e + 1] *= GSEL(single, y2_, 1.0f);
                    } else {
                        acc[1][bj][m][n][e] *= GSEL(single, 1.0f, q_); acc[1][bj][m][n][e + 1] *= GSEL(single, 1.0f, q2_);
                    }
                }
                __builtin_amdgcn_sched_barrier(0);
            }
    }
#undef GSEL
#undef GSCALE
}

template <int MODE> struct Epi {
    static constexpr bool PERM = true, AFTER_DRAIN = false;
    bf16_t* O; int ldc;
    bf16_t* O2; bf16_t* O3; float* OF; bf16_t* O4;
    __device__ __forceinline__ void operator()(f32x4 (&acc)[2][2][4][2], const Unit& u, int wr, int wc, int fr, int fq) const {
        const int row0 = u.pm * BM + wr * 64 + fr;
        const int cl0 = wc * 32 + 8 * fq;
        if constexpr (MODE == 2) {
            if (u.pn >= 6 && u.pn < 14) {
                const int chb = 128 * (u.pn - 6) + cl0;
#pragma unroll
                for (int ai = 0; ai < 2; ++ai)
#pragma unroll
                    for (int m = 0; m < 4; ++m) {
                        const size_t row = (size_t)(row0 + ai * HALF + m * 16);
                        float r[8], g[8];
#pragma unroll
                        for (int e = 0; e < 4; ++e) {
                            const float g0a = fmaxf(sigmoid_f(acc[ai][0][m][0][e]), 1e-13f), g0b = fmaxf(sigmoid_f(acc[ai][0][m][1][e]), 1e-13f);
                            const float g1a = fmaxf(sigmoid_f(acc[ai][1][m][0][e]), 1e-13f), g1b = fmaxf(sigmoid_f(acc[ai][1][m][1][e]), 1e-13f);
                            g[e] = g1a; g[4 + e] = g1b; r[e] = g0a * __builtin_amdgcn_rcpf(g1a); r[4 + e] = g0b * __builtin_amdgcn_rcpf(g1b);
                        }
                        u32x4 wr_, wg_; wr_.x = pk2(r[0], r[1]); wr_.y = pk2(r[2], r[3]); wr_.z = pk2(r[4], r[5]); wr_.w = pk2(r[6], r[7]);
                        wg_.x = pk2(g[0], g[1]); wg_.y = pk2(g[2], g[3]); wg_.z = pk2(g[4], g[5]); wg_.w = pk2(g[6], g[7]);
                        __builtin_nontemporal_store(wr_, (u32x4*)(O4 + row * 3072 + chb));
                        __builtin_nontemporal_store(wg_, (u32x4*)(O4 + row * 3072 + 1024 + chb));
                    }
                return;
            }
        }
#pragma unroll
        for (int ai = 0; ai < 2; ++ai)
#pragma unroll
            for (int m = 0; m < 4; ++m) {
                const size_t row = (size_t)(row0 + ai * HALF + m * 16);
#pragma unroll
                for (int bj = 0; bj < 2; ++bj) {
                    f32x4 v0 = acc[ai][bj][m][0], v1 = acc[ai][bj][m][1];
                    const int cl = cl0 + bj * HALF;
                    if constexpr (MODE == 0 || MODE == 1) {
                        if (MODE == 1) {
#pragma unroll
                            for (int e = 0; e < 4; ++e) { const float a = fmaxf(v0[e], 0.f), b = fmaxf(v1[e], 0.f); v0[e] = a * a; v1[e] = b * b; }
                        }
                        u32x4 w; w.x = pk2(v0[0], v0[1]); w.y = pk2(v0[2], v0[3]); w.z = pk2(v1[0], v1[1]); w.w = pk2(v1[2], v1[3]);
                        if constexpr (MODE == 1) __builtin_nontemporal_store(w, (u32x4*)(O + row * ldc + u.pn * BM + cl));
                        else *(u32x4*)(O + row * ldc + u.pn * BM + cl) = w;
                    } else if constexpr (MODE == 2) {
                        const int pn = u.pn;
                        if (pn == 4) {
                            u32x4 w; w.x = pk2(v0[0], v0[1]); w.y = pk2(v0[2], v0[3]); w.z = pk2(v1[0], v1[1]); w.w = pk2(v1[2], v1[3]);
                            *(u32x4*)((bf16_t*)OF + row * 256 + cl) = w;
                        } else {
                            bf16_t* dst;
                            if (pn < 2) { v0 = v0 * QSCALE; v1 = v1 * QSCALE; dst = O + row * 512 + pn * 256 + cl; }
                            else if (pn < 4) { dst = O2 + row * 512 + (pn - 2) * 256 + cl; }
                            else if (pn == 5) {
#pragma unroll
                                for (int e = 0; e < 4; ++e) { v0[e] = gelu_tanh_f(v0[e]); v1[e] = gelu_tanh_f(v1[e]); }
                                dst = O3 + row * 256 + cl;
                            } else {
#pragma unroll
                                for (int e = 0; e < 4; ++e) { v0[e] = fmaxf(sigmoid_f(v0[e]), 1e-13f); v1[e] = fmaxf(sigmoid_f(v1[e]), 1e-13f); }
                                dst = O4 + row * 3072 + (pn - 6) * 256 + cl;
                            }
                            u32x4 w; w.x = pk2(v0[0], v0[1]); w.y = pk2(v0[2], v0[3]); w.z = pk2(v1[0], v1[1]); w.w = pk2(v1[2], v1[3]);
                            if (pn >= 6) __builtin_nontemporal_store(w, (u32x4*)dst); else *(u32x4*)dst = w;
                        }
                    } else if constexpr (MODE == 3) {
                        bf16_t* dst; const size_t tokc = (size_t)(u.pn * BM + cl);
                        if (u.pm < 2) dst = O + ((tokc >> 5) * 512 + row) * 32 + (tokc & 31);
                        else {
#pragma unroll
                            for (int e = 0; e < 4; ++e) { v0[e] = gelu_tanh_f(v0[e]); v1[e] = gelu_tanh_f(v1[e]); }
                            dst = O2 + ((tokc >> 5) * 256 + (row - 512)) * 32 + (tokc & 31);
                        }
                        u32x4 w; w.x = pk2(v0[0], v0[1]); w.y = pk2(v0[2], v0[3]); w.z = pk2(v1[0], v1[1]); w.w = pk2(v1[2], v1[3]);
                        *(u32x4*)dst = w;
                    }
                }
            }
    }
};
struct SubUnit { const char* A; const char* B; int K; int pm, pn; int act; };
constexpr int ACT_KEEP = 64;
template <class Epi, class Sched, bool MERGE>
__device__ __forceinline__ void gemm_stream(PG8_LAS unsigned char* lds, const Sched& S, const Epi& E) {
    int tid_ = threadIdx.x; asm volatile("" : "+v"(tid_));
    const int tid = tid_, wid = __builtin_amdgcn_readfirstlane(tid >> 6), lane = tid & 63, wr = wid >> 2, wc = wid & 3, fr = lane & 15, fq = lane >> 4;
    unsigned rA0, rB0, c20;
    { int R, C; stage_rc(tid * 16, R, C); rA0 = (unsigned)R; rB0 = (unsigned)(Epi::PERM ? ((R & ~31) + perm32(R & 31)) : R); c20 = (unsigned)C * 2u; }
    const size_t kstep = (size_t)(BK * 2);
    const unsigned ldsw = (unsigned)wid * 1024u;
    const int aoff = lds_byte(wr * 64 + fr, fq * 8), boff = lds_byte(wc * 32 + fr, fq * 8);
#define PG8_SA(b, h) (((b) * 2 + (h)) * HTB)
#define PG8_SB(b, h) ((4 + (b) * 2 + (h)) * HTB)
#define PG8_STAGE(bufoff, gbase, v0, dv) do { _Pragma("unroll") for (int _i = 0; _i < 2; ++_i) \
        __builtin_amdgcn_global_load_lds((const unsigned*)((const char*)(gbase) + ((v0) + (unsigned)_i * (dv))), (PG8_LAS unsigned*)(lds + (bufoff) + ldsw + _i * 8192), 16, 0, 0); } while (0)
#define PG8_LDA(dst, b, h) do { _Pragma("unroll") for (int m = 0; m < 4; ++m) _Pragma("unroll") for (int k = 0; k < 2; ++k) dst[m][k] = *(const PG8_LAS bf16x8*)(lds + PG8_SA(b, h) + aoff + m * 2048 + k * 1024); } while (0)
#define PG8_LDB(dst, b, h) do { _Pragma("unroll") for (int n = 0; n < 2; ++n) _Pragma("unroll") for (int k = 0; k < 2; ++k) dst[n][k] = *(const PG8_LAS bf16x8*)(lds + PG8_SB(b, h) + boff + n * 2048 + k * 1024); } while (0)
#define PG8_MMA(ai, bj, At, Bt) do { __builtin_amdgcn_s_setprio(1); _Pragma("unroll") for (int m = 0; m < 4; ++m) _Pragma("unroll") for (int n = 0; n < 2; ++n) _Pragma("unroll") for (int k = 0; k < 2; ++k) \
        acc[ai][bj][m][n] = __builtin_amdgcn_mfma_f32_16x16x32_bf16(Bt[n][k], At[m][k], acc[ai][bj][m][n], 0, 0, 0); __builtin_amdgcn_s_setprio(0); } while (0)
#define PG8_WAIT_V(n) asm volatile("s_waitcnt vmcnt(" #n ")" ::: "memory")
#define PG8_WAIT_L(n) asm volatile("s_waitcnt lgkmcnt(" #n ")" ::: "memory")
#define PG8_BAR __builtin_amdgcn_s_barrier()
#define PG8_SCHED __builtin_amdgcn_sched_barrier(0)
    SubUnit cur, nxt; int ui = 0;
    if (!S.next(0, cur)) return;
    f32x4 acc[2][2][4][2];
#pragma unroll
    for (int a = 0; a < 2; ++a)
#pragma unroll
        for (int b = 0; b < 2; ++b)
#pragma unroll
            for (int m = 0; m < 4; ++m)
#pragma unroll
                for (int n = 0; n < 2; ++n) acc[a][b][m][n] = (f32x4){0.f, 0.f, 0.f, 0.f};
    bf16x8 At[4][2], B0[2][2], B1[2][2];
    const char* cA = cur.A; const char* cB = cur.B;
    size_t chs = (size_t)HALF * cur.K * 2;
    { const unsigned k2 = (unsigned)(2 * cur.K), cvA = rA0 * k2 + c20, cvB = rB0 * k2 + c20, cdv = 64u * k2;
    PG8_STAGE(PG8_SB(0, 0), cB, cvB, cdv); PG8_STAGE(PG8_SB(0, 1), cB + chs, cvB, cdv); PG8_STAGE(PG8_SA(0, 0), cA, cvA, cdv); PG8_STAGE(PG8_SA(0, 1), cA + chs, cvA, cdv);
    if (wr == 1) PG8_BAR;
    PG8_WAIT_V(2); PG8_BAR;
    PG8_STAGE(PG8_SB(1, 0), cB + kstep, cvB, cdv); PG8_STAGE(PG8_SA(1, 0), cA + kstep, cvA, cdv); PG8_STAGE(PG8_SB(1, 1), cB + chs + kstep, cvB, cdv);
    PG8_WAIT_V(6); PG8_BAR; }
    for (;;) {
        const bool has_next = S.next(ui + 1, nxt);
        if (!has_next) nxt = cur;
        const char* nA = nxt.A; const char* nB = nxt.B; const size_t nhs = (size_t)HALF * nxt.K * 2;
        const int nt = cur.K / BK; const unsigned ck2 = (unsigned)(2 * cur.K), nk2 = (unsigned)(2 * nxt.K);
        for (int t = 0; t < nt; t += 2) {
            const bool last = (t == nt - 2);
            const char* a1 = cA + (size_t)(t + 1) * kstep;
            const char* a2 = last ? nA : cA + (size_t)(t + 2) * kstep; const char* b2 = last ? nB : cB + (size_t)(t + 2) * kstep;
            const char* a3 = a2 + kstep; const char* b3 = b2 + kstep;
            const size_t hs2 = last ? nhs : chs;
            const unsigned k2b = last ? nk2 : ck2;
            const unsigned cvA = rA0 * ck2 + c20, cdv = 64u * ck2, vA2 = rA0 * k2b + c20, vB2 = rB0 * k2b + c20, dv2 = 64u * k2b;
            PG8_LDB(B0, 0, 0); PG8_LDB(B1, 0, 1); PG8_SCHED; PG8_LDA(At, 0, 0); PG8_STAGE(PG8_SA(1, 1), a1 + chs, cvA, cdv);
            PG8_WAIT_V(8); PG8_WAIT_L(0); PG8_BAR; PG8_MMA(0, 0, At, B0); PG8_MMA(0, 1, At, B1); PG8_BAR; PG8_SCHED;
            PG8_LDA(At, 0, 1); PG8_STAGE(PG8_SB(0, 0), b2, vB2, dv2); PG8_STAGE(PG8_SB(0, 1), b2 + hs2, vB2, dv2); PG8_STAGE(PG8_SA(0, 0), a2, vA2, dv2);
            PG8_WAIT_V(8); PG8_WAIT_L(0); PG8_BAR; PG8_MMA(1, 0, At, B0); PG8_MMA(1, 1, At, B1); PG8_BAR; PG8_SCHED;
            PG8_LDB(B0, 1, 0); PG8_LDB(B1, 1, 1); PG8_SCHED; PG8_LDA(At, 1, 0); PG8_STAGE(PG8_SA(0, 1), a2 + hs2, vA2, dv2);
            PG8_WAIT_V(8); PG8_WAIT_L(0); PG8_BAR; PG8_MMA(0, 0, At, B0); PG8_MMA(0, 1, At, B1); PG8_BAR; PG8_SCHED;
            PG8_LDA(At, 1, 1); PG8_STAGE(PG8_SB(1, 0), b3, vB2, dv2); PG8_STAGE(PG8_SB(1, 1), b3 + hs2, vB2, dv2); PG8_STAGE(PG8_SA(1, 0), a3, vA2, dv2);
            PG8_WAIT_V(8); PG8_WAIT_L(0); PG8_BAR; PG8_MMA(1, 0, At, B0); PG8_MMA(1, 1, At, B1); PG8_BAR; PG8_SCHED;
        }
        if (wr == 0) PG8_BAR;
        E(acc, cur, wr, wc, fr, fq);
        if (!has_next) break;
        if (!MERGE || !(cur.act & ACT_KEEP)) {
#pragma unroll
            for (int a = 0; a < 2; ++a)
#pragma unroll
                for (int b = 0; b < 2; ++b)
#pragma unroll
                    for (int m = 0; m < 4; ++m)
#pragma unroll
                        for (int n = 0; n < 2; ++n) acc[a][b][m][n] = (f32x4){0.f, 0.f, 0.f, 0.f};
        }
        cur = nxt; cA = nA; cB = nB; chs = nhs; ++ui;
        if (wr == 1) PG8_BAR;
    }
    PG8_WAIT_V(0);
    PG8_BAR;
#undef PG8_SA
#undef PG8_SB
#undef PG8_STAGE
#undef PG8_LDA
#undef PG8_LDB
#undef PG8_MMA
#undef PG8_WAIT_V
#undef PG8_WAIT_L
#undef PG8_BAR
#undef PG8_SCHED
}
}
constexpr int DM = 1024, NB = 4, SEQ = 8192, DEPTH = 4, NTOK = NB * SEQ;
constexpr int D_IN = 5376, D_FF = 4096;
constexpr int NWAVES = 8, NTHREADS = 512;
constexpr float RMS_EPS = 1e-6f;
constexpr size_t MiB = 1u << 20;
constexpr size_t WS_W = 2 * MiB;
constexpr size_t WS_H = 34 * MiB;
constexpr size_t WS_Y = 98 * MiB;
constexpr size_t WS_BIG = 162 * MiB;
constexpr size_t WS_END = 487 * MiB;
constexpr size_t WO_W1M = 0;
constexpr size_t WO_W1S = WO_W1M + (size_t)4608 * 1024;
constexpr size_t WO_WBS = WO_W1S + (size_t)768 * 1024;
constexpr size_t WO_WBP = WO_WBS + (size_t)1024 * 512;
constexpr size_t WO_WBG = WO_WBP + (size_t)1024 * 256;
constexpr size_t WO_WO  = WO_WBG + (size_t)1024 * 256;
constexpr size_t WO_WF1 = WO_WO + (size_t)1024 * 1024;
constexpr size_t WO_WF2 = WO_WF1 + (size_t)4096 * 1024;
constexpr size_t WO_WPT = WO_WF2 + (size_t)4096 * 1024;
static_assert((WO_WPT + 16384) * 2 <= 32 * MiB, "weight region");
constexpr int LDS_BYTES = 147456;

#define LAS __attribute__((address_space(3)))
typedef unsigned short bf16;
typedef unsigned v4u __attribute__((ext_vector_type(4)));
typedef unsigned v2u __attribute__((ext_vector_type(2)));
typedef float f32x4 __attribute__((ext_vector_type(4)));
typedef float f32x16 __attribute__((ext_vector_type(16)));
typedef short bf16x8 __attribute__((ext_vector_type(8)));
using pg8::pk2; using pg8::bf_lo; using pg8::bf_hi;
#define MFMA32(a, b, c) __builtin_amdgcn_mfma_f32_32x32x16_bf16((a), (b), (c), 0, 0, 0)
#define LDS_WAIT() asm volatile("s_waitcnt lgkmcnt(0)" ::: "memory")

__device__ __forceinline__ float wave_sum(float v) {
#pragma unroll
    for (int o = 1; o < 64; o <<= 1) v += __shfl_xor(v, o);
    return v;
}
__device__ __forceinline__ bf16x8 pack8(const float (&a)[8]) {
    v4u w; w.x = pk2(a[0], a[1]); w.y = pk2(a[2], a[3]); w.z = pk2(a[4], a[5]); w.w = pk2(a[6], a[7]);
    return __builtin_bit_cast(bf16x8, w);
}

__device__ __forceinline__ void transpose_item(const float* W, int K, int N, bf16* WT, int k0, int n0, int dst_row0, LAS float* scr, int lane) {
    float wv[32];
#pragma unroll
    for (int i = 0; i < 32; ++i) wv[i] = __builtin_nontemporal_load(W + (size_t)(k0 + 2 * i + (lane >> 5)) * N + n0 + (lane & 31));
#pragma unroll
    for (int i = 0; i < 32; ++i) scr[(2 * i + (lane >> 5)) * 33 + (lane & 31)] = wv[i];
    LDS_WAIT(); asm volatile("" ::: "memory");
    const int c = lane & 7;
#pragma unroll
    for (int j = 0; j < 4; ++j) { const int n = (lane >> 3) + 8 * j; const LAS float* s = scr + (8 * c) * 33 + n;
        v4u o; o.x = pk2(s[0 * 33], s[1 * 33]); o.y = pk2(s[2 * 33], s[3 * 33]); o.z = pk2(s[4 * 33], s[5 * 33]); o.w = pk2(s[6 * 33], s[7 * 33]);
        *(v4u*)(WT + (size_t)(dst_row0 + n) * K + k0 + 8 * c) = o; }
    LDS_WAIT(); asm volatile("" ::: "memory");
}

struct Args { const float* in[17]; float* out; unsigned char* ws; };

__device__ __forceinline__ void convert_weights(const Args& A, int l, LAS unsigned char* lds, int gw, int ngw, int wave, int lane) {
    bf16* WB = (bf16*)(A.ws + WS_W);
    LAS float* scr = (LAS float*)(lds + wave * 16384);
    const float* w_in = A.in[1] + (size_t)l * DM * D_IN;
    const float* w_bs = A.in[7] + (size_t)l * 512 * DM;
    const float* w_bp = A.in[8] + (size_t)l * 256 * DM;
    const float* w_bg = A.in[9] + (size_t)l * 256 * DM;
    const float* w_o  = A.in[10] + (size_t)l * DM * DM;
    const float* w_f1 = A.in[15] + (size_t)l * DM * D_FF;
    const float* w_f2 = A.in[16] + (size_t)l * D_FF * DM;
    constexpr int I_IN = 16 * 168, I_BS = 8 * 32, I_BP = 4 * 32, I_O = 16 * 32, I_F1 = 16 * 128, I_F2 = 64 * 32;
    constexpr int NITEMS = I_IN + I_BS + 2 * I_BP + I_O + I_F1 + I_F2;
    for (int it = gw; it < NITEMS; it += ngw) {
        int r = it;
        if (r < I_IN) { const int kb = r / 168, nb = r % 168, n0 = nb * 32;
            bf16* dst; int drow;
            if (n0 < 1024) { dst = WB + WO_W1M; drow = n0; }
            else if (n0 < 1536) { dst = WB + WO_W1S; drow = n0 - 1024; }
            else if (n0 < 2048) { dst = WB + WO_W1M; drow = n0 - 512; }
            else if (n0 < 2304) { dst = WB + WO_W1S; drow = n0 - 1536; }
            else { dst = WB + WO_W1M; const int gcol = n0 - 2304, br = gcol >> 10, ch = gcol & 1023;
                   drow = br == 2 ? 1536 + 2048 + ch : 1536 + (ch >> 7) * 256 + br * 128 + (ch & 127); }
            transpose_item(w_in, DM, D_IN, dst, kb * 64, n0, drow, scr, lane); continue; }
        r -= I_IN;
        if (r < I_BS) { transpose_item(w_bs, 512, DM, WB + WO_WBS, (r / 32) * 64, (r % 32) * 32, (r % 32) * 32, scr, lane); continue; } r -= I_BS;
        if (r < I_BP) { transpose_item(w_bp, 256, DM, WB + WO_WBP, (r / 32) * 64, (r % 32) * 32, (r % 32) * 32, scr, lane); continue; } r -= I_BP;
        if (r < I_BP) { transpose_item(w_bg, 256, DM, WB + WO_WBG, (r / 32) * 64, (r % 32) * 32, (r % 32) * 32, scr, lane); continue; } r -= I_BP;
        if (r < I_O)  { transpose_item(w_o, DM, DM, WB + WO_WO, (r / 32) * 64, (r % 32) * 32, (r % 32) * 32, scr, lane); continue; } r -= I_O;
        if (r < I_F1) { transpose_item(w_f1, DM, D_FF, WB + WO_WF1, (r / 128) * 64, (r % 128) * 32, (r % 128) * 32, scr, lane); continue; } r -= I_F1;
        transpose_item(w_f2, D_FF, DM, WB + WO_WF2, (r / 32) * 64, (r % 32) * 32, (r % 32) * 32, scr, lane);
    }
    const float* w_pool = A.in[2] + (size_t)l * 4 * 64 * 64; const float* pscale = A.in[3] + (size_t)l * 256;
    for (int e = gw * 64 + lane; e < 16384; e += ngw * 64) { const int g = e >> 12, o = (e >> 6) & 63, i = e & 63;
        const float v = w_pool[(g * 64 + i) * 64 + o] * pscale[g * 64 + o]; WB[WO_WPT + e] = (bf16)(pk2(v, 0.f) & 0xffffu); }
}

__device__ __forceinline__ void ew_init(const float* x, const float* gain, bf16* H, int gw, int ngw, int lane) {
    f32x4 g[4];
#pragma unroll
    for (int j = 0; j < 4; ++j) g[j] = *((const f32x4*)gain + lane + 64 * j);
    for (int m = gw; m < NTOK; m += ngw) {
        const f32x4* xr = (const f32x4*)(x + (size_t)m * DM) + lane; f32x4 v[4]; float s = 0.f;
#pragma unroll
        for (int j = 0; j < 4; ++j) { v[j] = __builtin_nontemporal_load(xr + 64 * j); s += (v[j].x * v[j].x + v[j].y * v[j].y) + (v[j].z * v[j].z + v[j].w * v[j].w); }
        const float rstd = rsqrtf(wave_sum(s) * (1.f / DM) + RMS_EPS);
        v2u* o = (v2u*)(H + (size_t)m * DM) + lane;
#pragma unroll
        for (int j = 0; j < 4; ++j) { v2u w; w.x = pk2(v[j].x * rstd * g[j].x, v[j].y * rstd * g[j].y); w.y = pk2(v[j].z * rstd * g[j].z, v[j].w * rstd * g[j].w); o[64 * j] = w; }
    }
}
constexpr int EW_NR = 4;
__device__ __forceinline__ void ew_post(const bf16* Y, const float* xin, float* xout, const float* gpost, const float* gnext, bf16* H, int gw, int ngw, int lane) {
    for (int m0 = EW_NR * gw; m0 < NTOK; m0 += EW_NR * ngw) {
        f32x4 y[EW_NR][4], xv[EW_NR][4]; float s[EW_NR];
#pragma unroll
        for (int q = 0; q < EW_NR; ++q) { const v2u* yr = (const v2u*)(Y + (size_t)(m0 + q) * DM) + lane; const f32x4* xr = (const f32x4*)(xin + (size_t)(m0 + q) * DM) + lane;
#pragma unroll
            for (int j = 0; j < 4; ++j) { const v2u w = __builtin_nontemporal_load(yr + 64 * j); y[q][j] = (f32x4){bf_lo(w.x), bf_hi(w.x), bf_lo(w.y), bf_hi(w.y)}; xv[q][j] = __builtin_nontemporal_load(xr + 64 * j); } }
#pragma unroll
        for (int q = 0; q < EW_NR; ++q) { s[q] = 0.f;
#pragma unroll
            for (int j = 0; j < 4; ++j) s[q] += (y[q][j].x * y[q][j].x + y[q][j].y * y[q][j].y) + (y[q][j].z * y[q][j].z + y[q][j].w * y[q][j].w); }
        float rstd[EW_NR], s2[EW_NR];
#pragma unroll
        for (int q = 0; q < EW_NR; ++q) { rstd[q] = rsqrtf(wave_sum(s[q]) * (1.f / DM) + RMS_EPS); s2[q] = 0.f; }
#pragma unroll
        for (int j = 0; j < 4; ++j) { const f32x4 g = *((const f32x4*)gpost + lane + 64 * j);
#pragma unroll
            for (int q = 0; q < EW_NR; ++q) { xv[q][j] = xv[q][j] + y[q][j] * rstd[q] * g; __builtin_nontemporal_store(xv[q][j], (f32x4*)(xout + (size_t)(m0 + q) * DM) + lane + 64 * j);
                s2[q] += (xv[q][j].x * xv[q][j].x + xv[q][j].y * xv[q][j].y) + (xv[q][j].z * xv[q][j].z + xv[q][j].w * xv[q][j].w); } }
        if (gnext) {
            float r2[EW_NR];
#pragma unroll
            for (int q = 0; q < EW_NR; ++q) r2[q] = rsqrtf(wave_sum(s2[q]) * (1.f / DM) + RMS_EPS);
#pragma unroll
            for (int j = 0; j < 4; ++j) { const f32x4 g = *((const f32x4*)gnext + lane + 64 * j);
#pragma unroll
                for (int q = 0; q < EW_NR; ++q) { v2u w; w.x = pk2(xv[q][j].x * r2[q] * g.x, xv[q][j].y * r2[q] * g.y); w.y = pk2(xv[q][j].z * r2[q] * g.z, xv[q][j].w * r2[q] * g.w);
                    *((v2u*)(H + (size_t)(m0 + q) * DM) + lane + 64 * j) = w; } }
        }
    }
}

__device__ __forceinline__ v4u pair_widen(v2u a, v2u b, int hh) {
    const unsigned s0 = hh ? a.x : b.x, s1 = hh ? a.y : b.y;
    const unsigned r0 = (unsigned)__shfl_xor((int)s0, 32), r1 = (unsigned)__shfl_xor((int)s1, 32);
    v4u w; if (hh == 0) { w.x = a.x; w.y = a.y; w.z = r0; w.w = r1; } else { w.x = r0; w.y = r1; w.z = b.x; w.w = b.y; }
    return w;
}

__device__ __forceinline__ void attn_unit(const bf16* Q, const bf16* Kb, const bf16* VT, bf16* OSB, int wu, int lane) {
    const int h = wu & 7, blk = wu >> 3, qblk = blk & 255, b = blk >> 8;
    const int r = lane & 31, hh = lane >> 5;
    const int pr = (r & 19) | ((r & 8) >> 1) | ((r & 4) << 1);
    const size_t tok0 = (size_t)b * SEQ + (size_t)qblk * 32;
    bf16x8 qf[4];
    { const bf16* qp = Q + (tok0 + r) * 512 + h * 64 + 8 * hh;
#pragma unroll
      for (int kk = 0; kk < 4; ++kk) qf[kk] = *(const bf16x8*)(qp + kk * 16); }
    const bf16* kbase = Kb + ((size_t)b * SEQ + pr) * 512 + h * 64 + 8 * hh;
    const bf16* vbase = VT + ((size_t)b * (SEQ / 32) * 512 + h * 64 + r) * 32 + 8 * hh;
    bf16x8 kf[4], vf[2][2];
    { const bf16* kp = kbase + (size_t)qblk * 32 * 512; const bf16* vp = vbase + (size_t)qblk * (512 * 32);
#pragma unroll
      for (int kk = 0; kk < 4; ++kk) kf[kk] = *(const bf16x8*)(kp + kk * 16);
#pragma unroll
      for (int mt = 0; mt < 2; ++mt)
#pragma unroll
          for (int s = 0; s < 2; ++s) vf[mt][s] = *(const bf16x8*)(vp + mt * 32 * 32 + 16 * s); }
    f32x16 o0, o1;
#pragma unroll
    for (int i = 0; i < 16; ++i) { o0[i] = 0.f; o1[i] = 0.f; }
    float carry = 0.f;
    for (int kt = qblk; kt >= 0; --kt) {
        bf16x8 kn[4], vn[2][2];
        { const int ktn = kt > 0 ? kt - 1 : 0; const bf16* kp = kbase + (size_t)ktn * 32 * 512; const bf16* vp = vbase + (size_t)ktn * (512 * 32);
#pragma unroll
          for (int kk = 0; kk < 4; ++kk) kn[kk] = *(const bf16x8*)(kp + kk * 16);
#pragma unroll
          for (int mt = 0; mt < 2; ++mt)
#pragma unroll
              for (int s = 0; s < 2; ++s) vn[mt][s] = *(const bf16x8*)(vp + mt * 32 * 32 + 16 * s); }
        f32x16 sc;
#pragma unroll
        for (int i = 0; i < 16; ++i) sc[i] = 0.f;
#pragma unroll
        for (int kk = 0; kk < 4; ++kk) sc = MFMA32(kf[kk], qf[kk], sc);
        const int lim = (kt == qblk) ? r : 64;
        float ln[16], ls[16];
#pragma unroll
        for (int i = 0; i < 16; ++i) {
            const float z = sc[i];
            const float l2 = __builtin_amdgcn_logf(1.0f + __builtin_amdgcn_exp2f(-fabsf(z)));
            const float sp = fmaxf(z, 0.f) + l2;
            const bool valid = (16 * (i >> 3) + 8 * hh + (i & 7)) < lim;
            ln[i] = valid ? -sp : 0.f;
            ls[i] = valid ? z - sp : -1e30f;
        }
        float ex[16], gs[2];
#pragma unroll
        for (int s = 0; s < 2; ++s) { float run = 0.f;
#pragma unroll
            for (int j = 7; j >= 0; --j) { ex[8 * s + j] = run; run += ln[8 * s + j]; }
            gs[s] = run; }
        const float pg0 = __shfl_xor(gs[0], 32), pg1 = __shfl_xor(gs[1], 32);
        const float off1 = (hh == 0 ? pg1 : 0.f) + carry;
        const float off0 = gs[1] + pg1 + (hh == 0 ? pg0 : 0.f) + carry;
        float a0[8], a1[8];
#pragma unroll
        for (int j = 0; j < 8; ++j) { a0[j] = __builtin_amdgcn_exp2f(ls[j] + ex[j] + off0); a1[j] = __builtin_amdgcn_exp2f(ls[8 + j] + ex[8 + j] + off1); }
        const bf16x8 p0 = pack8(a0), p1 = pack8(a1);
        o0 = MFMA32(vf[0][0], p0, o0); o0 = MFMA32(vf[0][1], p1, o0);
        o1 = MFMA32(vf[1][0], p0, o1); o1 = MFMA32(vf[1][1], p1, o1);
        carry += (gs[0] + gs[1]) + (pg0 + pg1);
        if (__all(carry < -60.f)) break;
#pragma unroll
        for (int kk = 0; kk < 4; ++kk) kf[kk] = kn[kk];
#pragma unroll
        for (int mt = 0; mt < 2; ++mt)
#pragma unroll
            for (int s = 0; s < 2; ++s) vf[mt][s] = vn[mt][s];
    }
    bf16* op = OSB + (tok0 + r) * 512 + h * 64;
#pragma unroll
    for (int mt = 0; mt < 2; ++mt)
#pragma unroll
        for (int gp = 0; gp < 2; ++gp) {
            const int g0 = 2 * gp, g1 = 2 * gp + 1;
            unsigned a0w, a1w, b0w, b1w;
            if (mt == 0) { a0w = pk2(o0[4 * g0], o0[4 * g0 + 1]); a1w = pk2(o0[4 * g0 + 2], o0[4 * g0 + 3]); b0w = pk2(o0[4 * g1], o0[4 * g1 + 1]); b1w = pk2(o0[4 * g1 + 2], o0[4 * g1 + 3]); }
            else         { a0w = pk2(o1[4 * g0], o1[4 * g0 + 1]); a1w = pk2(o1[4 * g0 + 2], o1[4 * g0 + 3]); b0w = pk2(o1[4 * g1], o1[4 * g1 + 1]); b1w = pk2(o1[4 * g1 + 2], o1[4 * g1 + 3]); }
            const unsigned s0 = hh ? a0w : b0w, s1 = hh ? a1w : b1w;
            const unsigned r0 = (unsigned)__shfl_xor((int)s0, 32), r1 = (unsigned)__shfl_xor((int)s1, 32);
            v4u w; if (hh == 0) { w.x = a0w; w.y = a1w; w.z = r0; w.w = r1; } else { w.x = r0; w.y = r1; w.z = b0w; w.w = b1w; }
            *(v4u*)(op + mt * 32 + 8 * (hh ? g1 : g0)) = w;
        }
}

__device__ __forceinline__ void pool_unit(const float* P, const bf16* WPT, bf16* OPOOL, int pu, int lane) {
    const int g = pu & 3, tb = pu >> 2, r = lane & 31, hh = lane >> 5;
    const int tok = tb * 32 + r, tl = tok & (SEQ - 1), w = 2 << g;
    const bf16* pp = (const bf16*)P + (size_t)tok * 256 + g * 64 + 8 * hh;
    f32x4 p0[4][2], s[4][2];
#define PL_UNPACK(dst0, dst1, w_) do { dst0 = (f32x4){bf_lo((w_).x), bf_hi((w_).x), bf_lo((w_).y), bf_hi((w_).y)}; dst1 = (f32x4){bf_lo((w_).z), bf_hi((w_).z), bf_lo((w_).w), bf_hi((w_).w)}; } while (0)
#pragma unroll
    for (int kk = 0; kk < 4; ++kk) { const v4u w_ = *(const v4u*)(pp + kk * 16); PL_UNPACK(p0[kk][0], p0[kk][1], w_); s[kk][0] = p0[kk][0]; s[kk][1] = p0[kk][1]; }
#pragma unroll 4
    for (int j = 1; j < w; ++j) {
        const bool ok = j <= tl; const float wg = ok ? 1.f : 0.f; const bf16* q = pp - (size_t)(ok ? j : 0) * 256;
#pragma unroll
        for (int kk = 0; kk < 4; ++kk) { const v4u w_ = *(const v4u*)(q + kk * 16); f32x4 a_, b_; PL_UNPACK(a_, b_, w_); s[kk][0] += wg * a_; s[kk][1] += wg * b_; }
    }
#undef PL_UNPACK
    const float inv = 1.0f / (float)(tl + 1 < w ? tl + 1 : w);
    f32x16 acc0, acc1;
#pragma unroll
    for (int i = 0; i < 16; ++i) { acc0[i] = 0.f; acc1[i] = 0.f; }
    const bf16* wp = WPT + (size_t)(g * 64 + r) * 64 + 8 * hh;
#pragma unroll
    for (int kk = 0; kk < 4; ++kk) {
        float a[8];
#pragma unroll
        for (int e = 0; e < 4; ++e) { a[e] = s[kk][0][e] * inv - p0[kk][0][e]; a[4 + e] = s[kk][1][e] * inv - p0[kk][1][e]; }
        const bf16x8 pf = pack8(a);
        acc0 = MFMA32(*(const bf16x8*)(wp + kk * 16), pf, acc0);
        acc1 = MFMA32(*(const bf16x8*)(wp + 32 * 64 + kk * 16), pf, acc1);
    }
    bf16* op = OPOOL + (size_t)tok * 256 + g * 64;
#pragma unroll
    for (int gp = 0; gp < 2; ++gp) {
        const int g0 = 2 * gp, g1 = 2 * gp + 1;
        v2u a, b;
        a.x = pk2(acc0[4 * g0], acc0[4 * g0 + 1]); a.y = pk2(acc0[4 * g0 + 2], acc0[4 * g0 + 3]); b.x = pk2(acc0[4 * g1], acc0[4 * g1 + 1]); b.y = pk2(acc0[4 * g1 + 2], acc0[4 * g1 + 3]);
        *(v4u*)(op + 8 * (hh ? g1 : g0)) = pair_widen(a, b, hh);
        a.x = pk2(acc1[4 * g0], acc1[4 * g0 + 1]); a.y = pk2(acc1[4 * g0 + 2], acc1[4 * g0 + 3]); b.x = pk2(acc1[4 * g1], acc1[4 * g1 + 1]); b.y = pk2(acc1[4 * g1 + 2], acc1[4 * g1 + 3]);
        *(v4u*)(op + 32 + 8 * (hh ? g1 : g0)) = pair_widen(a, b, hh);
    }
}

__device__ __forceinline__ void gmlp_unit(const bf16* GVT, const bf16* U, const float* wsp, const float* bsp, const float* gain, bf16* OGM, int unit, LAS unsigned char* lds, int tid, int wave, int lane) {
    LAS float* part = (LAS float*)lds;
    LAS float* rstd = part + 512;
    const size_t tok0 = (size_t)unit * 128;
    { const int p = tid & 127, cq = tid >> 7; const bf16* gp = GVT + (((tok0 + p) >> 5) * 256 + cq * 64) * 32 + (p & 31); float s = 0.f;
#pragma unroll
      for (int c = 0; c < 64; ++c) { const float v = __builtin_bit_cast(float, (unsigned)gp[c * 32] << 16); s += v * v; }
      part[cq * 128 + p] = s; }
    __syncthreads();
    if (tid < 128) rstd[tid] = rsqrtf((part[tid] + part[128 + tid] + part[256 + tid] + part[384 + tid]) * (1.f / 256.f) + RMS_EPS);
    __syncthreads();
    const int g = wave >> 1, th = wave & 1, r = lane & 31, hh = lane >> 5;
    f32x16 acc[2][2];
#pragma unroll
    for (int a = 0; a < 2; ++a)
#pragma unroll
        for (int b = 0; b < 2; ++b)
#pragma unroll
            for (int i = 0; i < 16; ++i) acc[a][b][i] = 0.f;
    const int nks = th ? 8 : 4;
    const bf16* ap = GVT + ((tok0 >> 5) * 256 + g * 64 + r) * 32 + 8 * hh;
    const float* wrow = wsp + (size_t)g * 128 * 128 + 8 * hh;
#pragma unroll 4
    for (int ks = 0; ks < nks; ++ks) {
        const bf16* apk = ap + (ks >> 1) * (256 * 32) + 16 * (ks & 1);
        const bf16x8 a0 = *(const bf16x8*)apk, a1 = *(const bf16x8*)(apk + 32 * 32);
        const int pb = 16 * ks + 8 * hh;
        float rs[8];
#pragma unroll
        for (int j = 0; j < 8; ++j) rs[j] = rstd[pb + j];
#pragma unroll
        for (int nt = 0; nt < 2; ++nt) {
            const int t = 64 * th + 32 * nt + r; const float* wq = wrow + (size_t)t * 128 + 16 * ks;
            const f32x4 w0 = *(const f32x4*)wq, w1 = *(const f32x4*)(wq + 4); float bv[8];
#pragma unroll
            for (int j = 0; j < 4; ++j) { bv[j] = (pb + j <= t) ? w0[j] * rs[j] : 0.f; bv[4 + j] = (pb + 4 + j <= t) ? w1[j] * rs[4 + j] : 0.f; }
            const bf16x8 bf = pack8(bv);
            acc[0][nt] = MFMA32(a0, bf, acc[0][nt]); acc[1][nt] = MFMA32(a1, bf, acc[1][nt]);
        }
    }
#pragma unroll
    for (int mt = 0; mt < 2; ++mt)
#pragma unroll
        for (int nt = 0; nt < 2; ++nt) {
            const int t = 64 * th + 32 * nt + r; const float bias = bsp[g * 128 + t];
#pragma unroll
            for (int gp = 0; gp < 2; ++gp) {
                v2u pc[2];
#pragma unroll
                for (int e = 0; e < 2; ++e) { const int q4 = 2 * gp + e;
                    const int c = g * 64 + mt * 32 + 8 * q4 + 4 * hh;
                    const f32x4 gn = *(const f32x4*)(gain + c);
                    const v2u uw = *(const v2u*)(U + (tok0 + t) * 256 + c);
                    const float v0 = (acc[mt][nt][4 * q4] * gn.x + bias) * bf_lo(uw.x), v1 = (acc[mt][nt][4 * q4 + 1] * gn.y + bias) * bf_hi(uw.x);
                    const float v2 = (acc[mt][nt][4 * q4 + 2] * gn.z + bias) * bf_lo(uw.y), v3 = (acc[mt][nt][4 * q4 + 3] * gn.w + bias) * bf_hi(uw.y);
                    pc[e].x = pk2(v0, v1); pc[e].y = pk2(v2, v3); }
                *(v4u*)(OGM + (tok0 + t) * 256 + g * 64 + mt * 32 + 8 * (2 * gp + hh)) = pair_widen(pc[0], pc[1], hh);
            }
        }
    __syncthreads();
}

#define XB_TMO      128
#define XB_XCNT(j)  (256  + 64 * (j))
#define XB_XSUB(j)  (1280 + 64 * (j))
#define XB_XGEN(j)  (2304 + 64 * (j))
#define XB_TOP      3328
#define XB_TOPGEN   3392
#define XCD_BAR_WORDS 3456
#define XB_SPIN_CAP (1u << 18)

__device__ __forceinline__ unsigned xb_ld(unsigned* p)              { return __hip_atomic_load(p, __ATOMIC_RELAXED, __HIP_MEMORY_SCOPE_AGENT); }
__device__ __forceinline__ unsigned xb_add(unsigned* p, unsigned v) { return __hip_atomic_fetch_add(p, v, __ATOMIC_RELAXED, __HIP_MEMORY_SCOPE_AGENT); }
__device__ __forceinline__ unsigned xb_xcc_id() { return (unsigned)__builtin_amdgcn_s_getreg((3 << 11) | 20) & 0xFu; }
#define XB_SPIN(cond, bar) do { unsigned _sp = 0; while (cond) { __builtin_amdgcn_s_sleep(1); \
    if ((++_sp & 255u) == 0u) { if (xb_ld(&(bar)[XB_TMO])) break; if (_sp > XB_SPIN_CAP) { atomicAdd(&(bar)[XB_TMO], 1u); break; } } } } while (0)

struct XcdBarrier {
    unsigned* bar; unsigned x;
    volatile LAS unsigned* st;
};

__device__ __forceinline__ XcdBarrier xcd_barrier_post(unsigned* bar, volatile LAS unsigned* st) {
    XcdBarrier b; b.bar = bar; b.x = xb_xcc_id(); b.st = st;
    if (threadIdx.x == 0) (void)xb_add(&bar[XB_XCNT(b.x)], 1u);
    return b;
}
__device__ __forceinline__ void xcd_barrier_complete(unsigned* bar, unsigned x, unsigned& nloc, unsigned& nx) {
    const unsigned G = gridDim.x * gridDim.y * gridDim.z;
    unsigned sum, cnt, mine, sp = 0u;
    for (;;) {
        sum = 0u; cnt = 0u; mine = 0u;
#pragma unroll
        for (unsigned j = 0; j < 16; ++j) { const unsigned c = xb_ld(&bar[XB_XCNT(j)]); sum += c; cnt += (c > 0u) ? 1u : 0u; mine = (j == x) ? c : mine; }
        if (sum == G) break;
        __builtin_amdgcn_s_sleep(1);
        if ((++sp & 255u) == 0u) { if (xb_ld(&bar[XB_TMO])) break; if (sp > XB_SPIN_CAP) { atomicAdd(&bar[XB_TMO], 1u); break; } }
    }
    nloc = mine > 0u ? mine : 1u; nx = cnt > 0u ? cnt : 1u;
}

__device__ __forceinline__ void xcd_barrier(const XcdBarrier& b) {
    asm volatile("s_waitcnt vmcnt(0)" ::: "memory");
    __syncthreads();
    if (threadIdx.x == 0) {
        unsigned* bar = b.bar;
        __builtin_amdgcn_s_waitcnt(0);
        unsigned nloc = b.st[0], nx = b.st[1];
        if (nloc == 0u) { xcd_barrier_complete(bar, b.x, nloc, nx); b.st[0] = nloc; b.st[1] = nx; }
        const unsigned old = xb_add(&bar[XB_XSUB(b.x)], 1u);
        const unsigned gen = old / nloc;
        if (old + 1u == (gen + 1u) * nloc) {
            __builtin_amdgcn_fence(__ATOMIC_RELEASE, "agent");
            asm volatile("s_waitcnt vmcnt(0)" ::: "memory");
            const unsigned og = xb_add(&bar[XB_TOP], 1u);
            const unsigned tg = og / nx;
            if (og + 1u == (tg + 1u) * nx) xb_add(&bar[XB_TOPGEN], 1u);
            else XB_SPIN(xb_ld(&bar[XB_TOPGEN]) == tg, bar);
            __builtin_amdgcn_fence(__ATOMIC_ACQUIRE, "agent");
            xb_add(&bar[XB_XGEN(b.x)], 1u);
            asm volatile("s_waitcnt vmcnt(0)" ::: "memory");
        } else {
            XB_SPIN(xb_ld(&bar[XB_XGEN(b.x)]) == gen, bar);
            __builtin_amdgcn_fence(__ATOMIC_ACQUIRE, "agent");
            asm volatile("s_waitcnt vmcnt(0)" ::: "memory");
        }
    }
    __syncthreads();
}

#ifndef OPSEQ_LIST
#define OPSEQ_LIST 0, 1, 2, 3, 6, 7, 8, 9, 10
#endif
__device__ const signed char OPSEQ[] = {OPSEQ_LIST};
constexpr int NOPS = sizeof(OPSEQ);
namespace pg8 {
struct EpiDyn {
    static constexpr bool PERM = true, AFTER_DRAIN = false;
    unsigned char* ws;
    __device__ __forceinline__ void operator()(f32x4 (&acc)[2][2][4][2], const SubUnit& su, int wr, int wc, int fr, int fq) const {
        const Unit u{su.pm, su.pn};
        bf16_t* const Yp = (bf16_t*)(ws + WS_Y); bf16_t* const Qp = (bf16_t*)(ws + WS_BIG); bf16_t* const Kp = Qp + (size_t)NTOK * 512; bf16_t* const VTp = Kp + (size_t)NTOK * 512;
        bf16_t* const Up = (bf16_t*)(ws + WS_BIG + 99 * MiB); bf16_t* const GVTp = Up + (size_t)NTOK * 256; bf16_t* const Gp = (bf16_t*)(ws + WS_BIG + 133 * MiB);
        switch (su.act & 63) {
            case 0: Epi<0>{Yp, DM, nullptr, nullptr, nullptr, nullptr}(acc, u, wr, wc, fr, fq); break;
            case 1: Epi<1>{Qp, D_FF, nullptr, nullptr, nullptr, nullptr}(acc, u, wr, wc, fr, fq); break;
            case 2: Epi<2>{Qp, 0, Kp, Up, (float*)(ws + WS_Y), Gp}(acc, u, wr, wc, fr, fq); break;
            default: Epi<3>{VTp, 0, GVTp, nullptr, nullptr, nullptr}(acc, u, wr, wc, fr, fq); break;
        }
    }
};
struct MergeEpi {
    static constexpr bool PERM = true, AFTER_DRAIN = false;
    unsigned char* ws;
    __device__ __forceinline__ void operator()(f32x4 (&acc)[2][2][4][2], const SubUnit& su, int wr, int wc, int fr, int fq) const {
        const Unit u{su.pm, su.pn}; const int br = (su.act & 63) - 6;
        bf16_t* const Qp = (bf16_t*)(ws + WS_BIG); bf16_t* const Gp = (bf16_t*)(ws + WS_BIG + 133 * MiB);
        scale_acc_by_gate_ratio(acc, Gp + br * 1024, br != 1, u, wr, wc, fr, fq);
        if (br == 2) Epi<0>{Qp, DM, nullptr, nullptr, nullptr, nullptr}(acc, u, wr, wc, fr, fq);
    }
};
struct GenSched {
    StaticOrder so; int merge; const char* A0; const char* B0; int K0; int act0;
    __device__ __forceinline__ bool next(int i, SubUnit& u) const {
        Unit t;
        if (!merge) { if (!so.next(i, t)) return false; u.A = A0 + (size_t)t.pm * (512 * (size_t)K0); u.B = B0 + (size_t)t.pn * (512 * (size_t)K0); u.K = K0; u.pm = t.pm; u.pn = t.pn; u.act = act0; return true; }
        const int ui = i / 3, br = i - 3 * ui;
        if (!so.next(ui, t)) return false;
        const int K = br == 0 ? 512 : 256; const char* a = A0 + (br == 0 ? (size_t)0 : (br == 1 ? (size_t)NTOK * 1024 : (size_t)NTOK * 1536)); const char* b = B0 + (br == 0 ? (size_t)0 : (br == 1 ? (size_t)1024 * 1024 : (size_t)1024 * 1536));
        u.A = a + (size_t)t.pm * (512 * (size_t)K); u.B = b + (size_t)t.pn * (512 * (size_t)K); u.K = K; u.pm = t.pm; u.pn = t.pn; u.act = br == 2 ? 8 : ((6 + br) | ACT_KEEP); return true;
    }
};
}
__global__ void __launch_bounds__(NTHREADS, 2) fwd_megakernel(Args A) {
    extern __shared__ __attribute__((aligned(16))) unsigned char lds_raw[];
    LAS unsigned char* lds = (LAS unsigned char*)lds_raw;
    cg::grid_group grid = cg::this_grid();
    const int G = gridDim.x;
    volatile LAS unsigned* bst = (volatile LAS unsigned*)(lds + 131072 + 64);
    unsigned* barw = (unsigned*)A.ws;
    if (threadIdx.x == 0) { bst[0] = 0u; bst[1] = 0u; }
    if (blockIdx.x == 0) for (int i = threadIdx.x; i < XCD_BAR_WORDS; i += NTHREADS) barw[i] = 0u;
    __syncthreads();
    XcdBarrier bar; bar.bar = barw; bar.x = 0; bar.st = bst;
#pragma nounroll
    for (int it = 0; it < 1 + DEPTH * NOPS; ++it) {
        int tid = threadIdx.x; asm volatile("" : "+v"(tid));
        const int lane = tid & 63, wave = __builtin_amdgcn_readfirstlane(tid >> 6);
        const int gw = blockIdx.x * NWAVES + wave, ngw = G * NWAVES;
        unsigned char* ws = A.ws;
        bf16* WB = (bf16*)(ws + WS_W);
        bf16* H = (bf16*)(ws + WS_H);
        bf16* OSB = H; bf16* OPOOL = H + (size_t)NTOK * 512; bf16* OGM = OPOOL + (size_t)NTOK * 256;
        float* P = (float*)(ws + WS_Y); bf16* Y = (bf16*)(ws + WS_Y);
        bf16* Qb = (bf16*)(ws + WS_BIG); bf16* Kb = Qb + (size_t)NTOK * 512; bf16* VT = Kb + (size_t)NTOK * 512;
        bf16* Ub = (bf16*)(ws + WS_BIG + 99 * MiB); bf16* GVT = Ub + (size_t)NTOK * 256; bf16* Gt = (bf16*)(ws + WS_BIG + 133 * MiB);
        bf16* MERGED = Qb; bf16* UF = Qb;
        float* xres = A.out;
        const int l = it == 0 ? -1 : (it - 1) / NOPS, k = it == 0 ? 10 : OPSEQ[(it - 1) % NOPS];
        bool sync_after = true;
        if (k == 10) {
            if (l + 1 < DEPTH) convert_weights(A, l + 1, lds, gw, ngw, wave, lane);
            if (it == 0) ew_init(A.in[0], A.in[11], H, gw, ngw, lane);
            else ew_post(Y, xres, xres, A.in[14] + (size_t)l * DM, l + 1 < DEPTH ? A.in[11] + (size_t)(l + 1) * DM : nullptr, H, gw, ngw, lane);
            sync_after = (l + 1 < DEPTH);
        } else if (k == 7) {
            ew_post(Y, l == 0 ? A.in[0] : xres, xres, A.in[12] + (size_t)l * DM, A.in[13] + (size_t)l * DM, H, gw, ngw, lane);
        } else if (k == 2) {
            for (int u = blockIdx.x; u < NTOK / 128; u += G)
                gmlp_unit(GVT, Ub, A.in[5] + (size_t)l * 4 * 128 * 128, A.in[6] + (size_t)l * 4 * 128, A.in[4] + (size_t)l * 256, OGM, u, lds, tid, wave, lane);
            for (int wu = gw; wu < 8192 + 4096; wu += ngw) {
                if (wu < 8192) attn_unit(Qb, Kb, VT, OSB, wu, lane);
                else pool_unit(P, WB + WO_WPT, OPOOL, wu - 8192, lane);
            }
        } else if (k == 3) {
            pg8::MergeEpi E{ws}; pg8::GenSched S; S.merge = 1; S.K0 = 512; S.act0 = 0; S.A0 = (const char*)OSB; S.B0 = (const char*)(WB + WO_WBS);
            S.so.init(NTOK, DM, G, (int)blockIdx.x);
            pg8::gemm_stream<pg8::MergeEpi, pg8::GenSched, true>(lds, S, E);
        } else {
            pg8::EpiDyn E{ws}; pg8::GenSched S; int gm = NTOK, gn = DM;
            S.merge = 0; S.K0 = DM;
            switch (k) {
                case 0: S.A0 = (const char*)(WB + WO_W1S); S.B0 = (const char*)H; gm = 768; gn = NTOK; S.act0 = 3; sync_after = false; break;
                case 1: S.A0 = (const char*)H; S.B0 = (const char*)(WB + WO_W1M); gn = 4608; S.act0 = 2; break;
                case 6: S.A0 = (const char*)MERGED; S.B0 = (const char*)(WB + WO_WO); S.act0 = 0; break;
                case 8: S.A0 = (const char*)H; S.B0 = (const char*)(WB + WO_WF1); gn = D_FF; S.act0 = 1; break;
                default: S.A0 = (const char*)UF; S.B0 = (const char*)(WB + WO_WF2); S.K0 = D_FF; S.act0 = 0; break;
            }
            S.so.init(gm, gn, G, (int)blockIdx.x);
            pg8::gemm_stream<pg8::EpiDyn, pg8::GenSched, false>(lds, S, E);
        }
        if (sync_after) { if (it == 0) { grid.sync(); bar = xcd_barrier_post(barw, bst); } else xcd_barrier(bar); }
    }
}

extern "C" void kernel_launch(void* const* d_in, const int* in_sizes, int n_in, void* d_out, int out_size, void* d_ws, size_t ws_size, hipStream_t stream) {
    static int grid = 0;
    if (grid == 0) {
        if (n_in != 17 || in_sizes[0] != NTOK * DM || out_size != NTOK * DM || ws_size < WS_END) { fprintf(stderr, "kernel_launch: unexpected shapes (n_in %d, ws %zu)\n", n_in, ws_size); grid = -1; return; }
        int dev = 0, cus = 0, per_cu = 0;
        if (hipGetDevice(&dev) != hipSuccess || hipDeviceGetAttribute(&cus, hipDeviceAttributeMultiprocessorCount, dev) != hipSuccess) { grid = -1; return; }
        if (hipFuncSetAttribute((const void*)fwd_megakernel, hipFuncAttributeMaxDynamicSharedMemorySize, LDS_BYTES) != hipSuccess) { fprintf(stderr, "kernel_launch: hipFuncSetAttribute failed\n"); grid = -1; return; }
        if (hipOccupancyMaxActiveBlocksPerMultiprocessor(&per_cu, (const void*)fwd_megakernel, NTHREADS, LDS_BYTES) != hipSuccess || per_cu < 1) { fprintf(stderr, "kernel_launch: occupancy query gave %d\n", per_cu); per_cu = 1; }
        (void)hipGetLastError();
        grid = cus * per_cu;
    }
    if (grid < 0) return;
    Args a{};
    for (int i = 0; i < 17; ++i) a.in[i] = (const float*)d_in[i];
    a.out = (float*)d_out; a.ws = (unsigned char*)d_ws;
    void* args[] = {&a};
    hipError_t e = hipLaunchCooperativeKernel((const void*)fwd_megakernel, dim3(grid), dim3(NTHREADS), args, LDS_BYTES, stream);
    if (e != hipSuccess) fprintf(stderr, "kernel_launch: cooperative launch failed: %s (grid %d)\n", hipGetErrorString(e), grid);
}
```

```cpp
#include <hip/hip_runtime.h>
#include <hip/hip_cooperative_groups.h>
#include <cstdio>
#include <cstdint>
namespace cg = cooperative_groups;
namespace pg8 {
#define PG8_LAS __attribute__((address_space(3)))
typedef unsigned short bf16_t;
typedef short bf16x8 __attribute__((ext_vector_type(8)));
typedef float f32x4 __attribute__((ext_vector_type(4)));
typedef unsigned u32x4 __attribute__((ext_vector_type(4)));
constexpr int BM = 256, BK = 64, HALF = 128, HTB = HALF * BK * 2  , STAGE_BYTES = 8 * HTB, NXCD = 8, WGM = 8;

__host__ __device__ __forceinline__ int lds_byte(int r, int c) { const int st = (r >> 4) * 2 + (c >> 5), rr = r & 15, cc = c & 31, ob = rr * 64 + cc * 2; return st * 1024 + (ob ^ (((ob >> 9) & 1) << 5)); }
__host__ __device__ __forceinline__ void stage_rc(int b, int& R, int& C) { const int st = b / 1024, sb = b % 1024, swz = sb ^ (((sb >> 9) & 1) << 5); R = (st >> 1) * 16 + swz / 64; C = (st & 1) * 32 + (swz % 64) / 2; }
__host__ __device__ __forceinline__ int perm32(int rho) { const int n = rho >> 4, i = rho & 15; return 8 * (i >> 2) + 4 * n + (i & 3); }

struct Unit { int pm, pn; };
struct Gemm { const bf16_t* A; const bf16_t* Bt; int M, N, K; };

struct StaticOrder {
    int nM, nN, nwg, G, c;
    __host__ __device__ void init(int M, int N, int G_, int c_) { nM = M / BM; nN = N / BM; nwg = nM * nN; G = G_; c = c_; }
    __host__ __device__ bool next(int i, Unit& u) const {
        const long L = (long)i * G + c; if (L >= nwg) return false;
        int wgid = (int)L; { const int q = nwg / NXCD, r = nwg % NXCD, xcd = wgid % NXCD, off = wgid / NXCD; wgid = (xcd < r ? xcd * (q + 1) : r * (q + 1) + (xcd - r) * q) + off; }
        const int nig = WGM * nN, gid = wgid / nig, fm = gid * WGM, gsz = (nM - fm) < WGM ? (nM - fm) : WGM;
        u.pm = fm + ((wgid % nig) % gsz); u.pn = (wgid % nig) / gsz; return true;
    }
    __device__ __forceinline__ void a_ready(const Unit&) const {}
    __device__ __forceinline__ void done(const Unit&) const {}
};

__device__ __forceinline__ unsigned cvt_pk_bf16(float lo, float hi) { unsigned r; asm volatile("v_cvt_pk_bf16_f32 %0, %1, %2" : "=v"(r) : "v"(lo), "v"(hi)); return r; }
typedef __bf16 bf16v2 __attribute__((ext_vector_type(2)));
typedef float f32v2 __attribute__((ext_vector_type(2)));
__device__ __forceinline__ unsigned pk2(float lo, float hi) { f32v2 v = {lo, hi}; bf16v2 r = __builtin_convertvector(v, bf16v2); return __builtin_bit_cast(unsigned, r); }
__device__ __forceinline__ float bf_lo(unsigned w) { return __builtin_bit_cast(float, w << 16); }
__device__ __forceinline__ float bf_hi(unsigned w) { return __builtin_bit_cast(float, w & 0xffff0000u); }
__device__ __forceinline__ float sigmoid_f(float x) { return __builtin_amdgcn_rcpf(1.0f + __builtin_amdgcn_exp2f(-1.4426950409f * x)); }
__device__ __forceinline__ float gelu_tanh_f(float x) { const float t = x * (1.0f + 0.044715f * x * x); return x * __builtin_amdgcn_rcpf(1.0f + __builtin_amdgcn_exp2f(-2.3022081981f * t)); }
constexpr float QSCALE = 0.125f * 1.4426950409f;

__device__ __forceinline__ void scale_acc_by_gate_ratio(f32x4 (&acc)[2][2][4][2], const bf16_t* ga_base, bool single, const Unit& u, int wr, int wc, int fr, int fq) {
    const size_t row0 = (size_t)(u.pm * BM + wr * 64 + fr); const int col0 = u.pn * BM + wc * 32 + 8 * fq;
    const bf16_t* gp = ga_base + row0 * 3072 + col0;
#define GSEL(c, a, b) ((c) ? (a) : (b))
#define GSCALE(AI, V, XW, YW, USEY) do { const float x_ = bf_lo(XW), x2_ = bf_hi(XW), y_ = bf_lo(YW), y2_ = bf_hi(YW); \
        const float f_ = (USEY) ? GSEL(single, y_, 1.0f) : GSEL(single, x_, x_ * __builtin_amdgcn_rcpf(y_)); \
        const float f2_ = (USEY) ? GSEL(single, y2_, 1.0f) : GSEL(single, x2_, x2_ * __builtin_amdgcn_rcpf(y2_)); (void)AI; V##A *= f_; V##B *= f2_; } while (0)
#pragma unroll
    for (int bt = 0; bt < 2; ++bt) {
        u32x4 X[8], Y[8];
#pragma unroll
        for (int m = 0; m < 4; ++m)
#pragma unroll
            for (int bj = 0; bj < 2; ++bj) {
                const bf16_t* p0 = gp + (size_t)(m * 16) * 3072 + bj * HALF; const bf16_t* p1 = p0 + (size_t)HALF * 3072;
                const bf16_t* px = bt == 0 ? p0 : GSEL(single, p0, p1);
                const bf16_t* py = bt == 0 ? GSEL(single, p1, p0 + 1024) : GSEL(single, p0, p1 + 1024);
                X[m * 2 + bj] = *(const u32x4*)px; Y[m * 2 + bj] = *(const u32x4*)py;
            }
        __builtin_amdgcn_sched_barrier(0);
#pragma unroll
        for (int m = 0; m < 4; ++m)
#pragma unroll
            for (int bj = 0; bj < 2; ++bj) {
                const u32x4 gx = X[m * 2 + bj], gy = Y[m * 2 + bj];
                const unsigned xw[4] = {gx.x, gx.y, gx.z, gx.w}, yw[4] = {gy.x, gy.y, gy.z, gy.w};
#pragma unroll
                for (int w = 0; w < 4; ++w) {
                    const float x_ = bf_lo(xw[w]), x2_ = bf_hi(xw[w]), y_ = bf_lo(yw[w]), y2_ = bf_hi(yw[w]);
                    const float q_ = x_ * __builtin_amdgcn_rcpf(y_), q2_ = x2_ * __builtin_amdgcn_rcpf(y2_);
                    const int n = w >> 1, e = (w & 1) * 2;
                    if (bt == 0) {
                        acc[0][bj][m][n][e] *= GSEL(single, x_, q_); acc[0][bj][m][n][e + 1] *= GSEL(single, x2_, q2_);
                        acc[1][bj][m][n][e] *= GSEL(single, y_, 1.0f); acc[1][bj][m][n][e + 1] *= GSEL(single, y2_, 1.0f);
                    } else {
                        acc[1][bj][m][n][e] *= GSEL(single, 1.0f, q_); acc[1][bj][m][n][e + 1] *= GSEL(single, 1.0f, q2_);
                    }
                }
                __builtin_amdgcn_sched_barrier(0);
            }
    }
#undef GSEL
#undef GSCALE
}

template <int MODE> struct Epi {
    static constexpr bool PERM = true, AFTER_DRAIN = false;
    bf16_t* O; int ldc;
    bf16_t* O2; bf16_t* O3; float* OF; bf16_t* O4;
    __device__ __forceinline__ void operator()(f32x4 (&acc)[2][2][4][2], const Unit& u, int wr, int wc, int fr, int fq) const {
        const int row0 = u.pm * BM + wr * 64 + fr;
        const int cl0 = wc * 32 + 8 * fq;
        if constexpr (MODE == 2) {
            if (u.pn >= 6 && u.pn < 14) {
                const int chb = 128 * (u.pn - 6) + cl0;
#pragma unroll
                for (int ai = 0; ai < 2; ++ai)
#pragma unroll
                    for (int m = 0; m < 4; ++m) {
                        const size_t row = (size_t)(row0 + ai * HALF + m * 16);
                        float r[8], g[8];
#pragma unroll
                        for (int e = 0; e < 4; ++e) {
                            const float g0a = fmaxf(sigmoid_f(acc[ai][0][m][0][e]), 1e-13f), g0b = fmaxf(sigmoid_f(acc[ai][0][m][1][e]), 1e-13f);
                            const float g1a = fmaxf(sigmoid_f(acc[ai][1][m][0][e]), 1e-13f), g1b = fmaxf(sigmoid_f(acc[ai][1][m][1][e]), 1e-13f);
                            g[e] = g1a; g[4 + e] = g1b; r[e] = g0a * __builtin_amdgcn_rcpf(g1a); r[4 + e] = g0b * __builtin_amdgcn_rcpf(g1b);
                        }
                        u32x4 wr_, wg_; wr_.x = pk2(r[0], r[1]); wr_.y = pk2(r[2], r[3]); wr_.z = pk2(r[4], r[5]); wr_.w = pk2(r[6], r[7]);
                        wg_.x = pk2(g[0], g[1]); wg_.y = pk2(g[2], g[3]); wg_.z = pk2(g[4], g[5]); wg_.w = pk2(g[6], g[7]);
                        __builtin_nontemporal_store(wr_, (u32x4*)(O4 + row * 3072 + chb));
                        __builtin_nontemporal_store(wg_, (u32x4*)(O4 + row * 3072 + 1024 + chb));
                    }
                return;
            }
        }
#pragma unroll
        for (int ai = 0; ai < 2; ++ai)
#pragma unroll
            for (int m = 0; m < 4; ++m) {
                const size_t row = (size_t)(row0 + ai * HALF + m * 16);
#pragma unroll
                for (int bj = 0; bj < 2; ++bj) {
                    f32x4 v0 = acc[ai][bj][m][0], v1 = acc[ai][bj][m][1];
                    const int cl = cl0 + bj * HALF;
                    if constexpr (MODE == 0 || MODE == 1) {
                        if (MODE == 1) {
#pragma unroll
                            for (int e = 0; e < 4; ++e) { const float a = fmaxf(v0[e], 0.f), b = fmaxf(v1[e], 0.f); v0[e] = a * a; v1[e] = b * b; }
                        }
                        u32x4 w; w.x = pk2(v0[0], v0[1]); w.y = pk2(v0[2], v0[3]); w.z = pk2(v1[0], v1[1]); w.w = pk2(v1[2], v1[3]);
                        if constexpr (MODE == 1) __builtin_nontemporal_store(w, (u32x4*)(O + row * ldc + u.pn * BM + cl));
                        else *(u32x4*)(O + row * ldc + u.pn * BM + cl) = w;
                    } else if constexpr (MODE == 2) {
                        const int pn = u.pn;
                        if (pn == 4) {
                            u32x4 w; w.x = pk2(v0[0], v0[1]); w.y = pk2(v0[2], v0[3]); w.z = pk2(v1[0], v1[1]); w.w = pk2(v1[2], v1[3]);
                            *(u32x4*)((bf16_t*)OF + row * 256 + cl) = w;
                        } else {
                            bf16_t* dst;
                            if (pn < 2) { v0 = v0 * QSCALE; v1 = v1 * QSCALE; dst = O + row * 512 + pn * 256 + cl; }
                            else if (pn < 4) { dst = O2 + row * 512 + (pn - 2) * 256 + cl; }
                            else if (pn == 5) {
#pragma unroll
                                for (int e = 0; e < 4; ++e) { v0[e] = gelu_tanh_f(v0[e]); v1[e] = gelu_tanh_f(v1[e]); }
                                dst = O3 + row * 256 + cl;
                            } else {
#pragma unroll
                                for (int e = 0; e < 4; ++e) { v0[e] = fmaxf(sigmoid_f(v0[e]), 1e-13f); v1[e] = fmaxf(sigmoid_f(v1[e]), 1e-13f); }
                                dst = O4 + row * 3072 + (pn - 6) * 256 + cl;
                            }
                            u32x4 w; w.x = pk2(v0[0], v0[1]); w.y = pk2(v0[2], v0[3]); w.z = pk2(v1[0], v1[1]); w.w = pk2(v1[2], v1[3]);
                            if (pn >= 6) __builtin_nontemporal_store(w, (u32x4*)dst); else *(u32x4*)dst = w;
                        }
                    } else if constexpr (MODE == 3) {
                        bf16_t* dst; const size_t tokc = (size_t)(u.pn * BM + cl);
                        if (u.pm < 2) dst = O + ((tokc >> 5) * 512 + row) * 32 + (tokc & 31);
                        else {
#pragma unroll
                            for (int e = 0; e < 4; ++e) { v0[e] = gelu_tanh_f(v0[e]); v1[e] = gelu_tanh_f(v1[e]); }
                            dst = O2 + ((tokc >> 5) * 256 + (row - 512)) * 32 + (tokc & 31);
                        }
                        u32x4 w; w.x = pk2(v0[0], v0[1]); w.y = pk2(v0[2], v0[3]); w.z = pk2(v1[0], v1[1]); w.w = pk2(v1[2], v1[3]);
                        *(u32x4*)dst = w;
                    }
                }
            }
    }
};
struct SubUnit { const char* A; const char* B; int K; int pm, pn; int act; };
constexpr int ACT_KEEP = 64;
template <class Epi, class Sched, bool MERGE>
__device__ __forceinline__ void gemm_stream(PG8_LAS unsigned char* lds, const Sched& S, const Epi& E) {
    int tid_ = threadIdx.x; asm volatile("" : "+v"(tid_));
    const int tid = tid_, wid = __builtin_amdgcn_readfirstlane(tid >> 6), lane = tid & 63, wr = wid >> 2, wc = wid & 3, fr = lane & 15, fq = lane >> 4;
    unsigned rA0, rB0, c20;
    { int R, C; stage_rc(tid * 16, R, C); rA0 = (unsigned)R; rB0 = (unsigned)(Epi::PERM ? ((R & ~31) + perm32(R & 31)) : R); c20 = (unsigned)C * 2u; }
    const size_t kstep = (size_t)(BK * 2);
    const unsigned ldsw = (unsigned)wid * 1024u;
    const int aoff = lds_byte(wr * 64 + fr, fq * 8), boff = lds_byte(wc * 32 + fr, fq * 8);
#define PG8_SA(b, h) (((b) * 2 + (h)) * HTB)
#define PG8_SB(b, h) ((4 + (b) * 2 + (h)) * HTB)
#define PG8_STAGE(bufoff, gbase, v0, dv) do { _Pragma("unroll") for (int _i = 0; _i < 2; ++_i) \
        __builtin_amdgcn_global_load_lds((const unsigned*)((const char*)(gbase) + ((v0) + (unsigned)_i * (dv))), (PG8_LAS unsigned*)(lds + (bufoff) + ldsw + _i * 8192), 16, 0, 0); } while (0)
#define PG8_LDA(dst, b, h) do { _Pragma("unroll") for (int m = 0; m < 4; ++m) _Pragma("unroll") for (int k = 0; k < 2; ++k) dst[m][k] = *(const PG8_LAS bf16x8*)(lds + PG8_SA(b, h) + aoff + m * 2048 + k * 1024); } while (0)
#define PG8_LDB(dst, b, h) do { _Pragma("unroll") for (int n = 0; n < 2; ++n) _Pragma("unroll") for (int k = 0; k < 2; ++k) dst[n][k] = *(const PG8_LAS bf16x8*)(lds + PG8_SB(b, h) + boff + n * 2048 + k * 1024); } while (0)
#define PG8_MMA(ai, bj, At, Bt) do { __builtin_amdgcn_s_setprio(1); _Pragma("unroll") for (int m = 0; m < 4; ++m) _Pragma("unroll") for (int n = 0; n < 2; ++n) _Pragma("unroll") for (int k = 0; k < 2; ++k) \
        acc[ai][bj][m][n] = __builtin_amdgcn_mfma_f32_16x16x32_bf16(Bt[n][k], At[m][k], acc[ai][bj][m][n], 0, 0, 0); __builtin_amdgcn_s_setprio(0); } while (0)
#define PG8_WAIT_V(n) asm volatile("s_waitcnt vmcnt(" #n ")" ::: "memory")
#define PG8_WAIT_L(n) asm volatile("s_waitcnt lgkmcnt(" #n ")" ::: "memory")
#define PG8_BAR __builtin_amdgcn_s_barrier()
#define PG8_SCHED __builtin_amdgcn_sched_barrier(0)
    SubUnit cur, nxt; int ui = 0;
    if (!S.next(0, cur)) return;
    f32x4 acc[2][2][4][2];
#pragma unroll
    for (int a = 0; a < 2; ++a)
#pragma unroll
        for (int b = 0; b < 2; ++b)
#pragma unroll
            for (int m = 0; m < 4; ++m)
#pragma unroll
                for (int n = 0; n < 2; ++n) acc[a][b][m][n] = (f32x4){0.f, 0.f, 0.f, 0.f};
    bf16x8 At[4][2], B0[2][2], B1[2][2];
    const char* cA = cur.A; const char* cB = cur.B;
    size_t chs = (size_t)HALF * cur.K * 2;
    { const unsigned k2 = (unsigned)(2 * cur.K), cvA = rA0 * k2 + c20, cvB = rB0 * k2 + c20, cdv = 64u * k2;
    PG8_STAGE(PG8_SB(0, 0), cB, cvB, cdv); PG8_STAGE(PG8_SB(0, 1), cB + chs, cvB, cdv); PG8_STAGE(PG8_SA(0, 0), cA, cvA, cdv); PG8_STAGE(PG8_SA(0, 1), cA + chs, cvA, cdv);
    if (wr == 1) PG8_BAR;
    PG8_WAIT_V(2); PG8_BAR;
    PG8_STAGE(PG8_SB(1, 0), cB + kstep, cvB, cdv); PG8_STAGE(PG8_SA(1, 0), cA + kstep, cvA, cdv); PG8_STAGE(PG8_SB(1, 1), cB + chs + kstep, cvB, cdv);
    PG8_WAIT_V(6); PG8_BAR; }
    for (;;) {
        const bool has_next = S.next(ui + 1, nxt);
        if (!has_next) nxt = cur;
        const char* nA = nxt.A; const char* nB = nxt.B; const size_t nhs = (size_t)HALF * nxt.K * 2;
        const int nt = cur.K / BK; const unsigned ck2 = (unsigned)(2 * cur.K), nk2 = (unsigned)(2 * nxt.K);
        for (int t = 0; t < nt; t += 2) {
            const bool last = (t == nt - 2);
            const char* a1 = cA + (size_t)(t + 1) * kstep;
            const char* a2 = last ? nA : cA + (size_t)(t + 2) * kstep; const char* b2 = last ? nB : cB + (size_t)(t + 2) * kstep;
            const char* a3 = a2 + kstep; const char* b3 = b2 + kstep;
            const size_t hs2 = last ? nhs : chs;
            const unsigned k2b = last ? nk2 : ck2;
            const unsigned cvA = rA0 * ck2 + c20, cdv = 64u * ck2, vA2 = rA0 * k2b + c20, vB2 = rB0 * k2b + c20, dv2 = 64u * k2b;
            PG8_LDB(B0, 0, 0); PG8_LDB(B1, 0, 1); PG8_SCHED; PG8_LDA(At, 0, 0); PG8_STAGE(PG8_SA(1, 1), a1 + chs, cvA, cdv);
            PG8_WAIT_V(8); PG8_WAIT_L(0); PG8_BAR; PG8_MMA(0, 0, At, B0); PG8_MMA(0, 1, At, B1); PG8_BAR; PG8_SCHED;
            PG8_LDA(At, 0, 1); PG8_STAGE(PG8_SB(0, 0), b2, vB2, dv2); PG8_STAGE(PG8_SB(0, 1), b2 + hs2, vB2, dv2); PG8_STAGE(PG8_SA(0, 0), a2, vA2, dv2);
            PG8_WAIT_V(8); PG8_WAIT_L(0); PG8_BAR; PG8_MMA(1, 0, At, B0); PG8_MMA(1, 1, At, B1); PG8_BAR; PG8_SCHED;
            PG8_LDB(B0, 1, 0); PG8_LDB(B1, 1, 1); PG8_SCHED; PG8_LDA(At, 1, 0); PG8_STAGE(PG8_SA(0, 1), a2 + hs2, vA2, dv2);
            PG8_WAIT_V(8); PG8_WAIT_L(0); PG8_BAR; PG8_MMA(0, 0, At, B0); PG8_MMA(0, 1, At, B1); PG8_BAR; PG8_SCHED;
            PG8_LDA(At, 1, 1); PG8_STAGE(PG8_SB(1, 0), b3, vB2, dv2); PG8_STAGE(PG8_SB(1, 1), b3 + hs2, vB2, dv2); PG8_STAGE(PG8_SA(1, 0), a3, vA2, dv2);
            PG8_WAIT_V(8); PG8_WAIT_L(0); PG8_BAR; PG8_MMA(1, 0, At, B0); PG8_MMA(1, 1, At, B1); PG8_BAR; PG8_SCHED;
        }
        if (wr == 0) PG8_BAR;
        E(acc, cur, wr, wc, fr, fq);
        if (!has_next) break;
        if (!MERGE || !(cur.act & ACT_KEEP)) {
#pragma unroll
            for (int a = 0; a < 2; ++a)
#pragma unroll
                for (int b = 0; b < 2; ++b)
#pragma unroll
                    for (int m = 0; m < 4; ++m)
#pragma unroll
                        for (int n = 0; n < 2; ++n) acc[a][b][m][n] = (f32x4){0.f, 0.f, 0.f, 0.f};
        }
        cur = nxt; cA = nA; cB = nB; chs = nhs; ++ui;
        if (wr == 1) PG8_BAR;
    }
    PG8_WAIT_V(0);
    PG8_BAR;
#undef PG8_SA
#undef PG8_SB
#undef PG8_STAGE
#undef PG8_LDA
#undef PG8_LDB
#undef PG8_MMA
#undef PG8_WAIT_V
#undef PG8_WAIT_L
#undef PG8_BAR
#undef PG8_SCHED
}
}
constexpr int DM = 1024, NB = 4, SEQ = 8192, DEPTH = 4, NTOK = NB * SEQ;
constexpr int D_IN = 5376, D_FF = 4096;
constexpr int NWAVES = 8, NTHREADS = 512;
constexpr float RMS_EPS = 1e-6f;
constexpr size_t MiB = 1u << 20;
constexpr size_t WS_W = 2 * MiB;
constexpr size_t WS_H = 34 * MiB;
constexpr size_t WS_Y = 98 * MiB;
constexpr size_t WS_BIG = 162 * MiB;
constexpr size_t WS_END = 487 * MiB;
constexpr size_t WO_W1M = 0;
constexpr size_t WO_W1S = WO_W1M + (size_t)4608 * 1024;
constexpr size_t WO_WBS = WO_W1S + (size_t)768 * 1024;
constexpr size_t WO_WBP = WO_WBS + (size_t)1024 * 512;
constexpr size_t WO_WBG = WO_WBP + (size_t)1024 * 256;
constexpr size_t WO_WO  = WO_WBG + (size_t)1024 * 256;
constexpr size_t WO_WF1 = WO_WO + (size_t)1024 * 1024;
constexpr size_t WO_WF2 = WO_WF1 + (size_t)4096 * 1024;
constexpr size_t WO_WPT = WO_WF2 + (size_t)4096 * 1024;
static_assert((WO_WPT + 16384) * 2 <= 32 * MiB, "weight region");
constexpr int LDS_BYTES = 147456;

#define LAS __attribute__((address_space(3)))
typedef unsigned short bf16;
typedef unsigned v4u __attribute__((ext_vector_type(4)));
typedef unsigned v2u __attribute__((ext_vector_type(2)));
typedef float f32x4 __attribute__((ext_vector_type(4)));
typedef float f32x16 __attribute__((ext_vector_type(16)));
typedef short bf16x8 __attribute__((ext_vector_type(8)));
using pg8::pk2; using pg8::bf_lo; using pg8::bf_hi;
#define MFMA32(a, b, c) __builtin_amdgcn_mfma_f32_32x32x16_bf16((a), (b), (c), 0, 0, 0)
#define LDS_WAIT() asm volatile("s_waitcnt lgkmcnt(0)" ::: "memory")

__device__ __forceinline__ float wave_sum(float v) {
#pragma unroll
    for (int o = 1; o < 64; o <<= 1) v += __shfl_xor(v, o);
    return v;
}
__device__ __forceinline__ bf16x8 pack8(const float (&a)[8]) {
    v4u w; w.x = pk2(a[0], a[1]); w.y = pk2(a[2], a[3]); w.z = pk2(a[4], a[5]); w.w = pk2(a[6], a[7]);
    return __builtin_bit_cast(bf16x8, w);
}

__device__ __forceinline__ void transpose_item(const float* W, int K, int N, bf16* WT, int k0, int n0, int dst_row0, LAS float* scr, int lane) {
    float wv[32];
#pragma unroll
    for (int i = 0; i < 32; ++i) wv[i] = __builtin_nontemporal_load(W + (size_t)(k0 + 2 * i + (lane >> 5)) * N + n0 + (lane & 31));
#pragma unroll
    for (int i = 0; i < 32; ++i) scr[(2 * i + (lane >> 5)) * 33 + (lane & 31)] = wv[i];
    LDS_WAIT(); asm volatile("" ::: "memory");
    const int c = lane & 7;
#pragma unroll
    for (int j = 0; j < 4; ++j) { const int n = (lane >> 3) + 8 * j; const LAS float* s = scr + (8 * c) * 33 + n;
        v4u o; o.x = pk2(s[0 * 33], s[1 * 33]); o.y = pk2(s[2 * 33], s[3 * 33]); o.z = pk2(s[4 * 33], s[5 * 33]); o.w = pk2(s[6 * 33], s[7 * 33]);
        *(v4u*)(WT + (size_t)(dst_row0 + n) * K + k0 + 8 * c) = o; }
    LDS_WAIT(); asm volatile("" ::: "memory");
}

struct Args { const float* in[17]; float* out; unsigned char* ws; };

__device__ __forceinline__ void convert_weights(const Args& A, int l, LAS unsigned char* lds, int gw, int ngw, int wave, int lane) {
    bf16* WB = (bf16*)(A.ws + WS_W);
    LAS float* scr = (LAS float*)(lds + wave * 16384);
    const float* w_in = A.in[1] + (size_t)l * DM * D_IN;
    const float* w_bs = A.in[7] + (size_t)l * 512 * DM;
    const float* w_bp = A.in[8] + (size_t)l * 256 * DM;
    const float* w_bg = A.in[9] + (size_t)l * 256 * DM;
    const float* w_o  = A.in[10] + (size_t)l * DM * DM;
    const float* w_f1 = A.in[15] + (size_t)l * DM * D_FF;
    const float* w_f2 = A.in[16] + (size_t)l * D_FF * DM;
    constexpr int I_IN = 16 * 168, I_BS = 8 * 32, I_BP = 4 * 32, I_O = 16 * 32, I_F1 = 16 * 128, I_F2 = 64 * 32;
    constexpr int NITEMS = I_IN + I_BS + 2 * I_BP + I_O + I_F1 + I_F2;
    for (int it = gw; it < NITEMS; it += ngw) {
        int r = it;
        if (r < I_IN) { const int kb = r / 168, nb = r % 168, n0 = nb * 32;
            bf16* dst; int drow;
            if (n0 < 1024) { dst = WB + WO_W1M; drow = n0; }
            else if (n0 < 1536) { dst = WB + WO_W1S; drow = n0 - 1024; }
            else if (n0 < 2048) { dst = WB + WO_W1M; drow = n0 - 512; }
            else if (n0 < 2304) { dst = WB + WO_W1S; drow = n0 - 1536; }
            else { dst = WB + WO_W1M; const int gcol = n0 - 2304, br = gcol >> 10, ch = gcol & 1023;
                   drow = br == 2 ? 1536 + 2048 + ch : 1536 + (ch >> 7) * 256 + br * 128 + (ch & 127); }
            transpose_item(w_in, DM, D_IN, dst, kb * 64, n0, drow, scr, lane); continue; }
        r -= I_IN;
        if (r < I_BS) { transpose_item(w_bs, 512, DM, WB + WO_WBS, (r / 32) * 64, (r % 32) * 32, (r % 32) * 32, scr, lane); continue; } r -= I_BS;
        if (r < I_BP) { transpose_item(w_bp, 256, DM, WB + WO_WBP, (r / 32) * 64, (r % 32) * 32, (r % 32) * 32, scr, lane); continue; } r -= I_BP;
        if (r < I_BP) { transpose_item(w_bg, 256, DM, WB + WO_WBG, (r / 32) * 64, (r % 32) * 32, (r % 32) * 32, scr, lane); continue; } r -= I_BP;
        if (r < I_O)  { transpose_item(w_o, DM, DM, WB + WO_WO, (r / 32) * 64, (r % 32) * 32, (r % 32) * 32, scr, lane); continue; } r -= I_O;
        if (r < I_F1) { transpose_item(w_f1, DM, D_FF, WB + WO_WF1, (r / 128) * 64, (r % 128) * 32, (r % 128) * 32, scr, lane); continue; } r -= I_F1;
        transpose_item(w_f2, D_FF, DM, WB + WO_WF2, (r / 32) * 64, (r % 32) * 32, (r % 32) * 32, scr, lane);
    }
    const float* w_pool = A.in[2] + (size_t)l * 4 * 64 * 64; const float* pscale = A.in[3] + (size_t)l * 256;
    for (int e = gw * 64 + lane; e < 16384; e += ngw * 64) { const int g = e >> 12, o = (e >> 6) & 63, i = e & 63;
        const float v = w_pool[(g * 64 + i) * 64 + o] * pscale[g * 64 + o]; WB[WO_WPT + e] = (bf16)(pk2(v, 0.f) & 0xffffu); }
}

__device__ __forceinline__ void ew_init(const float* x, const float* gain, bf16* H, int gw, int ngw, int lane) {
    f32x4 g[4];
#pragma unroll
    for (int j = 0; j < 4; ++j) g[j] = *((const f32x4*)gain + lane + 64 * j);
    for (int m = gw; m < NTOK; m += ngw) {
        const f32x4* xr = (const f32x4*)(x + (size_t)m * DM) + lane; f32x4 v[4]; float s = 0.f;
#pragma unroll
        for (int j = 0; j < 4; ++j) { v[j] = __builtin_nontemporal_load(xr + 64 * j); s += (v[j].x * v[j].x + v[j].y * v[j].y) + (v[j].z * v[j].z + v[j].w * v[j].w); }
        const float rstd = rsqrtf(wave_sum(s) * (1.f / DM) + RMS_EPS);
        v2u* o = (v2u*)(H + (size_t)m * DM) + lane;
#pragma unroll
        for (int j = 0; j < 4; ++j) { v2u w; w.x = pk2(v[j].x * rstd * g[j].x, v[j].y * rstd * g[j].y); w.y = pk2(v[j].z * rstd * g[j].z, v[j].w * rstd * g[j].w); o[64 * j] = w; }
    }
}
constexpr int EW_NR = 4;
__device__ __forceinline__ void ew_post(const bf16* Y, const float* xin, float* xout, const float* gpost, const float* gnext, bf16* H, int gw, int ngw, int lane) {
    for (int m0 = EW_NR * gw; m0 < NTOK; m0 += EW_NR * ngw) {
        f32x4 y[EW_NR][4], xv[EW_NR][4]; float s[EW_NR];
#pragma unroll
        for (int q = 0; q < EW_NR; ++q) { const v2u* yr = (const v2u*)(Y + (size_t)(m0 + q) * DM) + lane; const f32x4* xr = (const f32x4*)(xin + (size_t)(m0 + q) * DM) + lane;
#pragma unroll
            for (int j = 0; j < 4; ++j) { const v2u w = __builtin_nontemporal_load(yr + 64 * j); y[q][j] = (f32x4){bf_lo(w.x), bf_hi(w.x), bf_lo(w.y), bf_hi(w.y)}; xv[q][j] = __builtin_nontemporal_load(xr + 64 * j); } }
#pragma unroll
        for (int q = 0; q < EW_NR; ++q) { s[q] = 0.f;
#pragma unroll
            for (int j = 0; j < 4; ++j) s[q] += (y[q][j].x * y[q][j].x + y[q][j].y * y[q][j].y) + (y[q][j].z * y[q][j].z + y[q][j].w * y[q][j].w); }
        float rstd[EW_NR], s2[EW_NR];
#pragma unroll
        for (int q = 0; q < EW_NR; ++q) { rstd[q] = rsqrtf(wave_sum(s[q]) * (1.f / DM) + RMS_EPS); s2[q] = 0.f; }
#pragma unroll
        for (int j = 0; j < 4; ++j) { const f32x4 g = *((const f32x4*)gpost + lane + 64 * j);
#pragma unroll
            for (int q = 0; q < EW_NR; ++q) { xv[q][j] = xv[q][j] + y[q][j] * rstd[q] * g; __builtin_nontemporal_store(xv[q][j], (f32x4*)(xout + (size_t)(m0 + q) * DM) + lane + 64 * j);
                s2[q] += (xv[q][j].x * xv[q][j].x + xv[q][j].y * xv[q][j].y) + (xv[q][j].z * xv[q][j].z + xv[q][j].w * xv[q][j].w); } }
        if (gnext) {
            float r2[EW_NR];
#pragma unroll
            for (int q = 0; q < EW_NR; ++q) r2[q] = rsqrtf(wave_sum(s2[q]) * (1.f / DM) + RMS_EPS);
#pragma unroll
            for (int j = 0; j < 4; ++j) { const f32x4 g = *((const f32x4*)gnext + lane + 64 * j);
#pragma unroll
                for (int q = 0; q < EW_NR; ++q) { v2u w; w.x = pk2(xv[q][j].x * r2[q] * g.x, xv[q][j].y * r2[q] * g.y); w.y = pk2(xv[q][j].z * r2[q] * g.z, xv[q][j].w * r2[q] * g.w);
                    *((v2u*)(H + (size_t)(m0 + q) * DM) + lane + 64 * j) = w; } }
        }
    }
}

__device__ __forceinline__ v4u pair_widen(v2u a, v2u b, int hh) {
    const unsigned s0 = hh ? a.x : b.x, s1 = hh ? a.y : b.y;
    const unsigned r0 = (unsigned)__shfl_xor((int)s0, 32), r1 = (unsigned)__shfl_xor((int)s1, 32);
    v4u w; if (hh == 0) { w.x = a.x; w.y = a.y; w.z = r0; w.w = r1; } else { w.x = r0; w.y = r1; w.z = b.x; w.w = b.y; }
    return w;
}

__device__ __forceinline__ void attn_unit(const bf16* Q, const bf16* Kb, const bf16* VT, bf16* OSB, int wu, int lane) {
    const int h = wu & 7, blk = wu >> 3, qblk = blk & 255, b = blk >> 8;
    const int r = lane & 31, hh = lane >> 5;
    const int pr = (r & 19) | ((r & 8) >> 1) | ((r & 4) << 1);
    const size_t tok0 = (size_t)b * SEQ + (size_t)qblk * 32;
    bf16x8 qf[4];
    { const bf16* qp = Q + (tok0 + r) * 512 + h * 64 + 8 * hh;
#pragma unroll
      for (int kk = 0; kk < 4; ++kk) qf[kk] = *(const bf16x8*)(qp + kk * 16); }
    const bf16* kbase = Kb + ((size_t)b * SEQ + pr) * 512 + h * 64 + 8 * hh;
    const bf16* vbase = VT + ((size_t)b * (SEQ / 32) * 512 + h * 64 + r) * 32 + 8 * hh;
    bf16x8 kf[4], vf[2][2];
    { const bf16* kp = kbase + (size_t)qblk * 32 * 512; const bf16* vp = vbase + (size_t)qblk * (512 * 32);
#pragma unroll
      for (int kk = 0; kk < 4; ++kk) kf[kk] = *(const bf16x8*)(kp + kk * 16);
#pragma unroll
      for (int mt = 0; mt < 2; ++mt)
#pragma unroll
          for (int s = 0; s < 2; ++s) vf[mt][s] = *(const bf16x8*)(vp + mt * 32 * 32 + 16 * s); }
    f32x16 o0, o1;
#pragma unroll
    for (int i = 0; i < 16; ++i) { o0[i] = 0.f; o1[i] = 0.f; }
    float carry = 0.f;
    for (int kt = qblk; kt >= 0; --kt) {
        bf16x8 kn[4], vn[2][2];
        { const int ktn = kt > 0 ? kt - 1 : 0; const bf16* kp = kbase + (size_t)ktn * 32 * 512; const bf16* vp = vbase + (size_t)ktn * (512 * 32);
#pragma unroll
          for (int kk = 0; kk < 4; ++kk) kn[kk] = *(const bf16x8*)(kp + kk * 16);
#pragma unroll
          for (int mt = 0; mt < 2; ++mt)
#pragma unroll
              for (int s = 0; s < 2; ++s) vn[mt][s] = *(const bf16x8*)(vp + mt * 32 * 32 + 16 * s); }
        f32x16 sc;
#pragma unroll
        for (int i = 0; i < 16; ++i) sc[i] = 0.f;
#pragma unroll
        for (int kk = 0; kk < 4; ++kk) sc = MFMA32(kf[kk], qf[kk], sc);
        const int lim = (kt == qblk) ? r : 64;
        float ln[16], ls[16];
#pragma unroll
        for (int i = 0; i < 16; ++i) {
            const float z = sc[i];
            const float l2 = __builtin_amdgcn_logf(1.0f + __builtin_amdgcn_exp2f(-fabsf(z)));
            const float sp = fmaxf(z, 0.f) + l2;
            const bool valid = (16 * (i >> 3) + 8 * hh + (i & 7)) < lim;
            ln[i] = valid ? -sp : 0.f;
            ls[i] = valid ? z - sp : -1e30f;
        }
        float ex[16], gs[2];
#pragma unroll
        for (int s = 0; s < 2; ++s) { float run = 0.f;
#pragma unroll
            for (int j = 7; j >= 0; --j) { ex[8 * s + j] = run; run += ln[8 * s + j]; }
            gs[s] = run; }
        const float pg0 = __shfl_xor(gs[0], 32), pg1 = __shfl_xor(gs[1], 32);
        const float off1 = (hh == 0 ? pg1 : 0.f) + carry;
        const float off0 = gs[1] + pg1 + (hh == 0 ? pg0 : 0.f) + carry;
        float a0[8], a1[8];
#pragma unroll
        for (int j = 0; j < 8; ++j) { a0[j] = __builtin_amdgcn_exp2f(ls[j] + ex[j] + off0); a1[j] = __builtin_amdgcn_exp2f(ls[8 + j] + ex[8 + j] + off1); }
        const bf16x8 p0 = pack8(a0), p1 = pack8(a1);
        o0 = MFMA32(vf[0][0], p0, o0); o0 = MFMA32(vf[0][1], p1, o0);
        o1 = MFMA32(vf[1][0], p0, o1); o1 = MFMA32(vf[1][1], p1, o1);
        carry += (gs[0] + gs[1]) + (pg0 + pg1);
        if (__all(carry < -60.f)) break;
#pragma unroll
        for (int kk = 0; kk < 4; ++kk) kf[kk] = kn[kk];
#pragma unroll
        for (int mt = 0; mt < 2; ++mt)
#pragma unroll
            for (int s = 0; s < 2; ++s) vf[mt][s] = vn[mt][s];
    }
    bf16* op = OSB + (tok0 + r) * 512 + h * 64;
#pragma unroll
    for (int mt = 0; mt < 2; ++mt)
#pragma unroll
        for (int gp = 0; gp < 2; ++gp) {
            const int g0 = 2 * gp, g1 = 2 * gp + 1;
            unsigned a0w, a1w, b0w, b1w;
            if (mt == 0) { a0w = pk2(o0[4 * g0], o0[4 * g0 + 1]); a1w = pk2(o0[4 * g0 + 2], o0[4 * g0 + 3]); b0w = pk2(o0[4 * g1], o0[4 * g1 + 1]); b1w = pk2(o0[4 * g1 + 2], o0[4 * g1 + 3]); }
            else         { a0w = pk2(o1[4 * g0], o1[4 * g0 + 1]); a1w = pk2(o1[4 * g0 + 2], o1[4 * g0 + 3]); b0w = pk2(o1[4 * g1], o1[4 * g1 + 1]); b1w = pk2(o1[4 * g1 + 2], o1[4 * g1 + 3]); }
            const unsigned s0 = hh ? a0w : b0w, s1 = hh ? a1w : b1w;
            const unsigned r0 = (unsigned)__shfl_xor((int)s0, 32), r1 = (unsigned)__shfl_xor((int)s1, 32);
            v4u w; if (hh == 0) { w.x = a0w; w.y = a1w; w.z = r0; w.w = r1; } else { w.x = r0; w.y = r1; w.z = b0w; w.w = b1w; }
            *(v4u*)(op + mt * 32 + 8 * (hh ? g1 : g0)) = w;
        }
}

__device__ __forceinline__ void pool_unit(const float* P, const bf16* WPT, bf16* OPOOL, int pu, int lane) {
    const int g = pu & 3, tb = pu >> 2, r = lane & 31, hh = lane >> 5;
    const int tok = tb * 32 + r, tl = tok & (SEQ - 1), w = 2 << g;
    const bf16* pp = (const bf16*)P + (size_t)tok * 256 + g * 64 + 8 * hh;
    f32x4 p0[4][2], s[4][2];
#define PL_UNPACK(dst0, dst1, w_) do { dst0 = (f32x4){bf_lo((w_).x), bf_hi((w_).x), bf_lo((w_).y), bf_hi((w_).y)}; dst1 = (f32x4){bf_lo((w_).z), bf_hi((w_).z), bf_lo((w_).w), bf_hi((w_).w)}; } while (0)
#pragma unroll
    for (int kk = 0; kk < 4; ++kk) { const v4u w_ = *(const v4u*)(pp + kk * 16); PL_UNPACK(p0[kk][0], p0[kk][1], w_); s[kk][0] = p0[kk][0]; s[kk][1] = p0[kk][1]; }
    for (int j = 1; j < w; ++j) {
        const bool ok = j <= tl; const float wg = ok ? 1.f : 0.f; const bf16* q = pp - (size_t)(ok ? j : 0) * 256;
#pragma unroll
        for (int kk = 0; kk < 4; ++kk) { const v4u w_ = *(const v4u*)(q + kk * 16); f32x4 a_, b_; PL_UNPACK(a_, b_, w_); s[kk][0] += wg * a_; s[kk][1] += wg * b_; }
    }
#undef PL_UNPACK
    const float inv = 1.0f / (float)(tl + 1 < w ? tl + 1 : w);
    f32x16 acc0, acc1;
#pragma unroll
    for (int i = 0; i < 16; ++i) { acc0[i] = 0.f; acc1[i] = 0.f; }
    const bf16* wp = WPT + (size_t)(g * 64 + r) * 64 + 8 * hh;
#pragma unroll
    for (int kk = 0; kk < 4; ++kk) {
        float a[8];
#pragma unroll
        for (int e = 0; e < 4; ++e) { a[e] = s[kk][0][e] * inv - p0[kk][0][e]; a[4 + e] = s[kk][1][e] * inv - p0[kk][1][e]; }
        const bf16x8 pf = pack8(a);
        acc0 = MFMA32(*(const bf16x8*)(wp + kk * 16), pf, acc0);
        acc1 = MFMA32(*(const bf16x8*)(wp + 32 * 64 + kk * 16), pf, acc1);
    }
    bf16* op = OPOOL + (size_t)tok * 256 + g * 64;
#pragma unroll
    for (int gp = 0; gp < 2; ++gp) {
        const int g0 = 2 * gp, g1 = 2 * gp + 1;
        v2u a, b;
        a.x = pk2(acc0[4 * g0], acc0[4 * g0 + 1]); a.y = pk2(acc0[4 * g0 + 2], acc0[4 * g0 + 3]); b.x = pk2(acc0[4 * g1], acc0[4 * g1 + 1]); b.y = pk2(acc0[4 * g1 + 2], acc0[4 * g1 + 3]);
        *(v4u*)(op + 8 * (hh ? g1 : g0)) = pair_widen(a, b, hh);
        a.x = pk2(acc1[4 * g0], acc1[4 * g0 + 1]); a.y = pk2(acc1[4 * g0 + 2], acc1[4 * g0 + 3]); b.x = pk2(acc1[4 * g1], acc1[4 * g1 + 1]); b.y = pk2(acc1[4 * g1 + 2], acc1[4 * g1 + 3]);
        *(v4u*)(op + 32 + 8 * (hh ? g1 : g0)) = pair_widen(a, b, hh);
    }
}

__device__ __forceinline__ void gmlp_unit(const bf16* GVT, const bf16* U, const float* wsp, const float* bsp, const float* gain, bf16* OGM, int unit, LAS unsigned char* lds, int tid, int wave, int lane) {
    LAS float* part = (LAS float*)lds;
    LAS float* rstd = part + 4096;
    const size_t tok0 = (size_t)unit * 128;
    { const int o = tid & 3, ti = (tid >> 2) & 3, cg = tid >> 4;
      const bf16* gp = GVT + (((tok0 >> 5) + ti) * 256 + cg * 8) * 32 + 8 * o;
      v4u w[8];
#pragma unroll
      for (int cc = 0; cc < 8; ++cc) w[cc] = *(const v4u*)(gp + cc * 32);
      float ss[8];
#pragma unroll
      for (int j = 0; j < 8; ++j) ss[j] = 0.f;
#pragma unroll
      for (int cc = 0; cc < 8; ++cc) { const unsigned ww[4] = {w[cc].x, w[cc].y, w[cc].z, w[cc].w};
#pragma unroll
          for (int q = 0; q < 4; ++q) { const float a = bf_lo(ww[q]), b = bf_hi(ww[q]); ss[2 * q] += a * a; ss[2 * q + 1] += b * b; } }
      LAS float* pp = part + cg * 128 + ti * 32 + 8 * o;
#pragma unroll
      for (int j = 0; j < 8; ++j) pp[j] = ss[j]; }
    __syncthreads();
    if (tid < 128) { float s = 0.f;
#pragma unroll
        for (int cgi = 0; cgi < 32; ++cgi) s += part[cgi * 128 + tid];
        rstd[tid] = rsqrtf(s * (1.f / 256.f) + RMS_EPS); }
    __syncthreads();
    const int g = wave >> 1, th = wave & 1, r = lane & 31, hh = lane >> 5;
    f32x16 acc[2][2];
#pragma unroll
    for (int a = 0; a < 2; ++a)
#pragma unroll
        for (int b = 0; b < 2; ++b)
#pragma unroll
            for (int i = 0; i < 16; ++i) acc[a][b][i] = 0.f;
    const int nks = th ? 8 : 4;
    const bf16* ap = GVT + ((tok0 >> 5) * 256 + g * 64 + r) * 32 + 8 * hh;
    const float* wrow = wsp + (size_t)g * 128 * 128 + 8 * hh;
#pragma unroll 4
    for (int ks = 0; ks < nks; ++ks) {
        const bf16* apk = ap + (ks >> 1) * (256 * 32) + 16 * (ks & 1);
        const bf16x8 a0 = *(const bf16x8*)apk, a1 = *(const bf16x8*)(apk + 32 * 32);
        const int pb = 16 * ks + 8 * hh;
        float rs[8];
#pragma unroll
        for (int j = 0; j < 8; ++j) rs[j] = rstd[pb + j];
#pragma unroll
        for (int nt = 0; nt < 2; ++nt) {
            const int t = 64 * th + 32 * nt + r; const float* wq = wrow + (size_t)t * 128 + 16 * ks;
            const f32x4 w0 = *(const f32x4*)wq, w1 = *(const f32x4*)(wq + 4); float bv[8];
#pragma unroll
            for (int j = 0; j < 4; ++j) { bv[j] = (pb + j <= t) ? w0[j] * rs[j] : 0.f; bv[4 + j] = (pb + 4 + j <= t) ? w1[j] * rs[4 + j] : 0.f; }
            const bf16x8 bf = pack8(bv);
            acc[0][nt] = MFMA32(a0, bf, acc[0][nt]); acc[1][nt] = MFMA32(a1, bf, acc[1][nt]);
        }
    }
#pragma unroll
    for (int mt = 0; mt < 2; ++mt)
#pragma unroll
        for (int nt = 0; nt < 2; ++nt) {
            const int t = 64 * th + 32 * nt + r; const float bias = bsp[g * 128 + t];
#pragma unroll
            for (int gp = 0; gp < 2; ++gp) {
                v2u pc[2];
#pragma unroll
                for (int e = 0; e < 2; ++e) { const int q4 = 2 * gp + e;
                    const int c = g * 64 + mt * 32 + 8 * q4 + 4 * hh;
                    const f32x4 gn = *(const f32x4*)(gain + c);
                    const v2u uw = *(const v2u*)(U + (tok0 + t) * 256 + c);
                    const float v0 = (acc[mt][nt][4 * q4] * gn.x + bias) * bf_lo(uw.x), v1 = (acc[mt][nt][4 * q4 + 1] * gn.y + bias) * bf_hi(uw.x);
                    const float v2 = (acc[mt][nt][4 * q4 + 2] * gn.z + bias) * bf_lo(uw.y), v3 = (acc[mt][nt][4 * q4 + 3] * gn.w + bias) * bf_hi(uw.y);
                    pc[e].x = pk2(v0, v1); pc[e].y = pk2(v2, v3); }
                *(v4u*)(OGM + (tok0 + t) * 256 + g * 64 + mt * 32 + 8 * (2 * gp + hh)) = pair_widen(pc[0], pc[1], hh);
            }
        }
    __syncthreads();
}

#define XB_TMO      128
#define XB_XCNT(j)  (256  + 64 * (j))
#define XB_XSUB(j)  (1280 + 64 * (j))
#define XB_XGEN(j)  (2304 + 64 * (j))
#define XB_TOP      3328
#define XB_TOPGEN   3392
#define XCD_BAR_WORDS 3456
#define XB_SPIN_CAP (1u << 18)

__device__ __forceinline__ unsigned xb_ld(unsigned* p)              { return __hip_atomic_load(p, __ATOMIC_RELAXED, __HIP_MEMORY_SCOPE_AGENT); }
__device__ __forceinline__ unsigned xb_add(unsigned* p, unsigned v) { return __hip_atomic_fetch_add(p, v, __ATOMIC_RELAXED, __HIP_MEMORY_SCOPE_AGENT); }
__device__ __forceinline__ unsigned xb_xcc_id() { return (unsigned)__builtin_amdgcn_s_getreg((3 << 11) | 20) & 0xFu; }
#define XB_SPIN(cond, bar) do { unsigned _sp = 0; while (cond) { __builtin_amdgcn_s_sleep(1); \
    if ((++_sp & 255u) == 0u) { if (xb_ld(&(bar)[XB_TMO])) break; if (_sp > XB_SPIN_CAP) { atomicAdd(&(bar)[XB_TMO], 1u); break; } } } } while (0)

struct XcdBarrier {
    unsigned* bar; unsigned x;
    volatile LAS unsigned* st;
};

__device__ __forceinline__ XcdBarrier xcd_barrier_post(unsigned* bar, volatile LAS unsigned* st) {
    XcdBarrier b; b.bar = bar; b.x = xb_xcc_id(); b.st = st;
    if (threadIdx.x == 0) (void)xb_add(&bar[XB_XCNT(b.x)], 1u);
    return b;
}
__device__ __forceinline__ void xcd_barrier_complete(unsigned* bar, unsigned x, unsigned& nloc, unsigned& nx) {
    const unsigned G = gridDim.x * gridDim.y * gridDim.z;
    unsigned sum, cnt, mine, sp = 0u;
    for (;;) {
        sum = 0u; cnt = 0u; mine = 0u;
#pragma unroll
        for (unsigned j = 0; j < 16; ++j) { const unsigned c = xb_ld(&bar[XB_XCNT(j)]); sum += c; cnt += (c > 0u) ? 1u : 0u; mine = (j == x) ? c : mine; }
        if (sum == G) break;
        __builtin_amdgcn_s_sleep(1);
        if ((++sp & 255u) == 0u) { if (xb_ld(&bar[XB_TMO])) break; if (sp > XB_SPIN_CAP) { atomicAdd(&bar[XB_TMO], 1u); break; } }
    }
    nloc = mine > 0u ? mine : 1u; nx = cnt > 0u ? cnt : 1u;
}

__device__ __forceinline__ void xcd_barrier(const XcdBarrier& b) {
    asm volatile("s_waitcnt vmcnt(0)" ::: "memory");
    __syncthreads();
    if (threadIdx.x == 0) {
        unsigned* bar = b.bar;
        __builtin_amdgcn_s_waitcnt(0);
        unsigned nloc = b.st[0], nx = b.st[1];
        if (nloc == 0u) { xcd_barrier_complete(bar, b.x, nloc, nx); b.st[0] = nloc; b.st[1] = nx; }
        const unsigned old = xb_add(&bar[XB_XSUB(b.x)], 1u);
        const unsigned gen = old / nloc;
        if (old + 1u == (gen + 1u) * nloc) {
            __builtin_amdgcn_fence(__ATOMIC_RELEASE, "agent");
            asm volatile("s_waitcnt vmcnt(0)" ::: "memory");
            const unsigned og = xb_add(&bar[XB_TOP], 1u);
            const unsigned tg = og / nx;
            if (og + 1u == (tg + 1u) * nx) xb_add(&bar[XB_TOPGEN], 1u);
            else XB_SPIN(xb_ld(&bar[XB_TOPGEN]) == tg, bar);
            __builtin_amdgcn_fence(__ATOMIC_ACQUIRE, "agent");
            xb_add(&bar[XB_XGEN(b.x)], 1u);
            asm volatile("s_waitcnt vmcnt(0)" ::: "memory");
        } else {
            XB_SPIN(xb_ld(&bar[XB_XGEN(b.x)]) == gen, bar);
            __builtin_amdgcn_fence(__ATOMIC_ACQUIRE, "agent");
            asm volatile("s_waitcnt vmcnt(0)" ::: "memory");
        }
    }
    __syncthreads();
}

#ifndef OPSEQ_LIST
#define OPSEQ_LIST 0, 1, 2, 3, 6, 7, 8, 9, 10
#endif
__device__ const signed char OPSEQ[] = {OPSEQ_LIST};
constexpr int NOPS = sizeof(OPSEQ);
namespace pg8 {
struct EpiDyn {
    static constexpr bool PERM = true, AFTER_DRAIN = false;
    unsigned char* ws;
    __device__ __forceinline__ void operator()(f32x4 (&acc)[2][2][4][2], const SubUnit& su, int wr, int wc, int fr, int fq) const {
        const Unit u{su.pm, su.pn};
        bf16_t* const Yp = (bf16_t*)(ws + WS_Y); bf16_t* const Qp = (bf16_t*)(ws + WS_BIG); bf16_t* const Kp = Qp + (size_t)NTOK * 512; bf16_t* const VTp = Kp + (size_t)NTOK * 512;
        bf16_t* const Up = (bf16_t*)(ws + WS_BIG + 99 * MiB); bf16_t* const GVTp = Up + (size_t)NTOK * 256; bf16_t* const Gp = (bf16_t*)(ws + WS_BIG + 133 * MiB);
        switch (su.act & 63) {
            case 0: Epi<0>{Yp, DM, nullptr, nullptr, nullptr, nullptr}(acc, u, wr, wc, fr, fq); break;
            case 1: Epi<1>{Qp, D_FF, nullptr, nullptr, nullptr, nullptr}(acc, u, wr, wc, fr, fq); break;
            case 2: Epi<2>{Qp, 0, Kp, Up, (float*)(ws + WS_Y), Gp}(acc, u, wr, wc, fr, fq); break;
            default: Epi<3>{VTp, 0, GVTp, nullptr, nullptr, nullptr}(acc, u, wr, wc, fr, fq); break;
        }
    }
};
struct MergeEpi {
    static constexpr bool PERM = true, AFTER_DRAIN = false;
    unsigned char* ws;
    __device__ __forceinline__ void operator()(f32x4 (&acc)[2][2][4][2], const SubUnit& su, int wr, int wc, int fr, int fq) const {
        const Unit u{su.pm, su.pn}; const int br = (su.act & 63) - 6;
        bf16_t* const Qp = (bf16_t*)(ws + WS_BIG); bf16_t* const Gp = (bf16_t*)(ws + WS_BIG + 133 * MiB);
        scale_acc_by_gate_ratio(acc, Gp + br * 1024, br != 1, u, wr, wc, fr, fq);
        if (br == 2) Epi<0>{Qp, DM, nullptr, nullptr, nullptr, nullptr}(acc, u, wr, wc, fr, fq);
    }
};
struct GenSched {
    StaticOrder so; int merge; const char* A0; const char* B0; int K0; int act0;
    __device__ __forceinline__ bool next(int i, SubUnit& u) const {
        Unit t;
        if (!merge) { if (!so.next(i, t)) return false; u.A = A0 + (size_t)t.pm * (512 * (size_t)K0); u.B = B0 + (size_t)t.pn * (512 * (size_t)K0); u.K = K0; u.pm = t.pm; u.pn = t.pn; u.act = act0; return true; }
        const int ui = i / 3, br = i - 3 * ui;
        if (!so.next(ui, t)) return false;
        const int K = br == 0 ? 512 : 256; const char* a = A0 + (br == 0 ? (size_t)0 : (br == 1 ? (size_t)NTOK * 1024 : (size_t)NTOK * 1536)); const char* b = B0 + (br == 0 ? (size_t)0 : (br == 1 ? (size_t)1024 * 1024 : (size_t)1024 * 1536));
        u.A = a + (size_t)t.pm * (512 * (size_t)K); u.B = b + (size_t)t.pn * (512 * (size_t)K); u.K = K; u.pm = t.pm; u.pn = t.pn; u.act = br == 2 ? 8 : ((6 + br) | ACT_KEEP); return true;
    }
};
}
__global__ void __launch_bounds__(NTHREADS, 2) fwd_megakernel(Args A) {
    extern __shared__ __attribute__((aligned(16))) unsigned char lds_raw[];
    LAS unsigned char* lds = (LAS unsigned char*)lds_raw;
    cg::grid_group grid = cg::this_grid();
    const int G = gridDim.x;
    volatile LAS unsigned* bst = (volatile LAS unsigned*)(lds + 131072 + 64);
    unsigned* barw = (unsigned*)A.ws;
    if (threadIdx.x == 0) { bst[0] = 0u; bst[1] = 0u; }
    if (blockIdx.x == 0) for (int i = threadIdx.x; i < XCD_BAR_WORDS; i += NTHREADS) barw[i] = 0u;
    __syncthreads();
    XcdBarrier bar; bar.bar = barw; bar.x = 0; bar.st = bst;
#pragma nounroll
    for (int it = 0; it < 1 + DEPTH * NOPS; ++it) {
        int tid = threadIdx.x; asm volatile("" : "+v"(tid));
        const int lane = tid & 63, wave = __builtin_amdgcn_readfirstlane(tid >> 6);
        const int gw = blockIdx.x * NWAVES + wave, ngw = G * NWAVES;
        unsigned char* ws = A.ws;
        bf16* WB = (bf16*)(ws + WS_W);
        bf16* H = (bf16*)(ws + WS_H);
        bf16* OSB = H; bf16* OPOOL = H + (size_t)NTOK * 512; bf16* OGM = OPOOL + (size_t)NTOK * 256;
        float* P = (float*)(ws + WS_Y); bf16* Y = (bf16*)(ws + WS_Y);
        bf16* Qb = (bf16*)(ws + WS_BIG); bf16* Kb = Qb + (size_t)NTOK * 512; bf16* VT = Kb + (size_t)NTOK * 512;
        bf16* Ub = (bf16*)(ws + WS_BIG + 99 * MiB); bf16* GVT = Ub + (size_t)NTOK * 256; bf16* Gt = (bf16*)(ws + WS_BIG + 133 * MiB);
        bf16* MERGED = Qb; bf16* UF = Qb;
        float* xres = A.out;
        const int l = it == 0 ? -1 : (it - 1) / NOPS, k = it == 0 ? 10 : OPSEQ[(it - 1) % NOPS];
        bool sync_after = true;
        if (k == 10) {
            if (l + 1 < DEPTH) convert_weights(A, l + 1, lds, gw, ngw, wave, lane);
            if (it == 0) ew_init(A.in[0], A.in[11], H, gw, ngw, lane);
            else ew_post(Y, xres, xres, A.in[14] + (size_t)l * DM, l + 1 < DEPTH ? A.in[11] + (size_t)(l + 1) * DM : nullptr, H, gw, ngw, lane);
            sync_after = (l + 1 < DEPTH);
        } else if (k == 7) {
            ew_post(Y, l == 0 ? A.in[0] : xres, xres, A.in[12] + (size_t)l * DM, A.in[13] + (size_t)l * DM, H, gw, ngw, lane);
        } else if (k == 2) {
            for (int u = blockIdx.x; u < NTOK / 128; u += G)
                gmlp_unit(GVT, Ub, A.in[5] + (size_t)l * 4 * 128 * 128, A.in[6] + (size_t)l * 4 * 128, A.in[4] + (size_t)l * 256, OGM, u, lds, tid, wave, lane);
            for (int wu = gw; wu < 8192 + 4096; wu += ngw) {
                if (wu < 8192) attn_unit(Qb, Kb, VT, OSB, wu, lane);
                else pool_unit(P, WB + WO_WPT, OPOOL, wu - 8192, lane);
            }
        } else if (k == 3) {
            pg8::MergeEpi E{ws}; pg8::GenSched S; S.merge = 1; S.K0 = 512; S.act0 = 0; S.A0 = (const char*)OSB; S.B0 = (const char*)(WB + WO_WBS);
            S.so.init(NTOK, DM, G, (int)blockIdx.x);
            pg8::gemm_stream<pg8::MergeEpi, pg8::GenSched, true>(lds, S, E);
        } else {
            pg8::EpiDyn E{ws}; pg8::GenSched S; int gm = NTOK, gn = DM;
            S.merge = 0; S.K0 = DM;
            switch (k) {
                case 0: S.A0 = (const char*)(WB + WO_W1S); S.B0 = (const char*)H; gm = 768; gn = NTOK; S.act0 = 3; sync_after = false; break;
                case 1: S.A0 = (const char*)H; S.B0 = (const char*)(WB + WO_W1M); gn = 4608; S.act0 = 2; break;
                case 6: S.A0 = (const char*)MERGED; S.B0 = (const char*)(WB + WO_WO); S.act0 = 0; break;
                case 8: S.A0 = (const char*)H; S.B0 = (const char*)(WB + WO_WF1); gn = D_FF; S.act0 = 1; break;
                default: S.A0 = (const char*)UF; S.B0 = (const char*)(WB + WO_WF2); S.K0 = D_FF; S.act0 = 0; break;
            }
            S.so.init(gm, gn, G, (int)blockIdx.x);
            pg8::gemm_stream<pg8::EpiDyn, pg8::GenSched, false>(lds, S, E);
        }
        if (sync_after) { if (it == 0) { grid.sync(); bar = xcd_barrier_post(barw, bst); } else xcd_barrier(bar); }
    }
}

extern "C" void kernel_launch(void* const* d_in, const int* in_sizes, int n_in, void* d_out, int out_size, void* d_ws, size_t ws_size, hipStream_t stream) {
    static int grid = 0;
    if (grid == 0) {
        if (n_in != 17 || in_sizes[0] != NTOK * DM || out_size != NTOK * DM || ws_size < WS_END) { fprintf(stderr, "kernel_launch: unexpected shapes (n_in %d, ws %zu)\n", n_in, ws_size); grid = -1; return; }
        int dev = 0, cus = 0, per_cu = 0;
        if (hipGetDevice(&dev) != hipSuccess || hipDeviceGetAttribute(&cus, hipDeviceAttributeMultiprocessorCount, dev) != hipSuccess) { grid = -1; return; }
        if (hipFuncSetAttribute((const void*)fwd_megakernel, hipFuncAttributeMaxDynamicSharedMemorySize, LDS_BYTES) != hipSuccess) { fprintf(stderr, "kernel_launch: hipFuncSetAttribute failed\n"); grid = -1; return; }
        if (hipOccupancyMaxActiveBlocksPerMultiprocessor(&per_cu, (const void*)fwd_megakernel, NTHREADS, LDS_BYTES) != hipSuccess || per_cu < 1) { fprintf(stderr, "kernel_launch: occupancy query gave %d\n", per_cu); per_cu = 1; }
        (void)hipGetLastError();
        grid = cus * per_cu;
    }
    if (grid < 0) return;
    Args a{};
    for (int i = 0; i < 17; ++i) a.in[i] = (const float*)d_in[i];
    a.out = (float*)d_out; a.ws = (unsigned char*)d_ws;
    void* args[] = {&a};
    hipError_t e = hipLaunchCooperativeKernel((const void*)fwd_megakernel, dim3(grid), dim3(NTHREADS), args, LDS_BYTES, stream);
    if (e != hipSuccess) fprintf(stderr, "kernel_launch: cooperative launch failed: %s (grid %d)\n", hipGetErrorString(e), grid);
}
```
